# Optimizing an MI355X kernel written in HIP

```python
import math
import jax, jax.numpy as jnp
from jax import lax
import numpy as np

D_MODEL = 1024
BATCH = 4
SEQ = 4096
DEPTH = 1

N_META = 16
EPS = 1e-6
D_FF = 2816
MLA_HEADS = 8
MLA_Q_RANK = 256
MLA_KV_RANK = 128
MLA_NOPE = 64
MLA_ROPE = 32
MLA_V = 64
ROPE_THETA = 10000.0
Q_BLOCK = 128
GDN_HEADS = 8
GDN_DK = 64
GDN_DV = 64
CONV_K = 4
CHUNK = 64
SPLITS = (MLA_Q_RANK, MLA_KV_RANK, MLA_ROPE,
          GDN_HEADS * GDN_DK, GDN_HEADS * GDN_DK, GDN_HEADS * GDN_DV,
          GDN_HEADS, GDN_HEADS, GDN_HEADS * GDN_DV,
          D_MODEL, D_MODEL)
D_IN = sum(SPLITS)
GDN_CONV_CH = 2 * GDN_HEADS * GDN_DK + GDN_HEADS * GDN_DV

kernel_name = 'hybrid_mla_gdn_macaron_block'


def rmsnorm(x, w):
    x32 = x.astype(jnp.float32)
    y = x32 * lax.rsqrt(jnp.mean(x32 * x32, axis=-1, keepdims=True) + EPS)
    return (y * w.astype(jnp.float32)).astype(x.dtype)


def swiglu(x, w_gate, w_up, w_down):
    return (jax.nn.silu(x @ w_gate) * (x @ w_up)) @ w_down


def rope_tables(length):
    pos = jnp.arange(length, dtype=jnp.float32)
    inv = ROPE_THETA ** (-jnp.arange(0, MLA_ROPE, 2, dtype=jnp.float32) / MLA_ROPE)
    ang = pos[:, None] * inv[None, :]
    return jnp.cos(ang), jnp.sin(ang)


def apply_rope(x, cos, sin):
    half = x.shape[-1] // 2
    x1 = x[..., :half].astype(jnp.float32)
    x2 = x[..., half:].astype(jnp.float32)
    out = jnp.concatenate([x1 * cos - x2 * sin, x2 * cos + x1 * sin], axis=-1)
    return out.astype(x.dtype)


def mla(c_q_raw, c_kv_raw, k_rope_raw, q_norm, w_uq, kv_norm, w_ukv):
    b, length, _ = c_q_raw.shape
    q = (rmsnorm(c_q_raw, q_norm) @ w_uq).reshape(b, length, MLA_HEADS, MLA_NOPE + MLA_ROPE)
    kv = (rmsnorm(c_kv_raw, kv_norm) @ w_ukv).reshape(b, length, MLA_HEADS, MLA_NOPE + MLA_V)
    q_nope, q_rope = q[..., :MLA_NOPE], q[..., MLA_NOPE:]
    k_nope, v = kv[..., :MLA_NOPE], kv[..., MLA_NOPE:]
    cos, sin = rope_tables(length)
    q_rope = apply_rope(q_rope, cos[:, None, :], sin[:, None, :])
    k_rope = apply_rope(k_rope_raw, cos, sin)
    scale = (MLA_NOPE + MLA_ROPE) ** -0.5
    n_blk = -(-length // Q_BLOCK)
    l_pad = n_blk * Q_BLOCK

    def to_blocks(t):
        t = jnp.pad(t, ((0, 0), (0, l_pad - length), (0, 0), (0, 0)))
        return t.reshape(b, n_blk, Q_BLOCK, MLA_HEADS, t.shape[-1]).transpose(1, 0, 2, 3, 4)

    qn_blocks = to_blocks(q_nope)
    qr_blocks = to_blocks(q_rope)
    starts = jnp.arange(n_blk, dtype=jnp.int32) * Q_BLOCK
    k_pos = jnp.arange(length, dtype=jnp.int32)

    def attend_block(args):
        qn_b, qr_b, start = args
        s = (jnp.einsum('bqhd,bkhd->bhqk', qn_b, k_nope)
             + jnp.einsum('bqhd,bkd->bhqk', qr_b, k_rope)).astype(jnp.float32) * scale
        q_pos = start + jnp.arange(Q_BLOCK, dtype=jnp.int32)
        causal = k_pos[None, :] <= q_pos[:, None]
        s = jnp.where(causal, s, -jnp.inf)
        p = jax.nn.softmax(s, axis=-1).astype(v.dtype)
        return jnp.einsum('bhqk,bkhd->bqhd', p, v)

    o = lax.map(attend_block, (qn_blocks, qr_blocks, starts))
    o = o.transpose(1, 0, 2, 3, 4).reshape(b, l_pad, MLA_HEADS * MLA_V)
    return o[:, :length]


def short_conv(x, w):
    ch = x.shape[-1]
    return lax.conv_general_dilated(
        x, w[:, None, :].astype(x.dtype), window_strides=(1,),
        padding=[(CONV_K - 1, 0)], dimension_numbers=('NWC', 'WIO', 'NWC'),
        feature_group_count=ch)


def l2norm(x):
    return x * lax.rsqrt(jnp.sum(x * x, axis=-1, keepdims=True) + EPS)


def gated_deltanet(q_raw, k_raw, v_raw, b_raw, a_raw, z_raw, conv_w, a_log, dt_bias, gdn_norm):
    b, length, _ = q_raw.shape
    dtype = q_raw.dtype
    qkv = jax.nn.silu(short_conv(jnp.concatenate([q_raw, k_raw, v_raw], axis=-1), conv_w))
    nq = GDN_HEADS * GDN_DK
    q = qkv[..., :nq].reshape(b, length, GDN_HEADS, GDN_DK).astype(jnp.float32)
    k = qkv[..., nq:2 * nq].reshape(b, length, GDN_HEADS, GDN_DK).astype(jnp.float32)
    v = qkv[..., 2 * nq:].reshape(b, length, GDN_HEADS, GDN_DV).astype(jnp.float32)
    q = l2norm(q) * (GDN_DK ** -0.5)
    k = l2norm(k)
    beta = jax.nn.sigmoid(b_raw.astype(jnp.float32))
    g = -jnp.exp(a_log.astype(jnp.float32)) * jax.nn.softplus(
        a_raw.astype(jnp.float32) + dt_bias.astype(jnp.float32))

    pad_front = (-N_META) % CHUNK
    lc = pad_front + length
    n_chunk = lc // CHUNK

    def to_chunks(t):
        t = jnp.pad(t, ((0, 0), (pad_front, 0)) + ((0, 0),) * (t.ndim - 2))
        t = t.reshape((b, n_chunk, CHUNK) + t.shape[2:])
        return jnp.moveaxis(t, 3, 1)

    qc, kc, vc = to_chunks(q), to_chunks(k), to_chunks(v)
    bc = to_chunks(beta)
    gc = jnp.cumsum(to_chunks(g), axis=-1)
    tri_incl = jnp.tril(jnp.ones((CHUNK, CHUNK), dtype=bool))
    tri_strict = jnp.tril(jnp.ones((CHUNK, CHUNK), dtype=bool), -1)
    diff = gc[..., :, None] - gc[..., None, :]
    decay = jnp.exp(jnp.where(tri_incl, diff, -jnp.inf))
    kb = kc * bc[..., None]
    lmat = jnp.where(tri_strict, jnp.einsum('bhncd,bhnsd->bhncs', kb, kc) * decay, 0.0)
    eye = jnp.eye(CHUNK, dtype=jnp.float32)
    tmat = lax.linalg.triangular_solve(eye + lmat, jnp.broadcast_to(eye, lmat.shape),
                                       left_side=True, lower=True)
    u_c = tmat @ (vc * bc[..., None])
    w_c = tmat @ (kb * jnp.exp(gc)[..., None])
    intra = jnp.einsum('bhncd,bhnsd->bhncs', qc, kc) * decay

    def step(state, inp):
        q_i, k_i, u_i, w_i, g_i, a_i = inp
        v_new = u_i - w_i @ state
        o_i = (q_i * jnp.exp(g_i)[..., None]) @ state + a_i @ v_new
        g_last = g_i[..., -1]
        k_dec = k_i * jnp.exp(g_last[..., None] - g_i)[..., None]
        state = state * jnp.exp(g_last)[..., None, None] + jnp.einsum('bhcd,bhce->bhde', k_dec, v_new)
        return state, o_i

    xs = tuple(jnp.moveaxis(t, 2, 0) for t in (qc, kc, u_c, w_c, gc, intra))
    s0 = jnp.zeros((b, GDN_HEADS, GDN_DK, GDN_DV), jnp.float32)
    _, o = lax.scan(step, s0, xs)
    o = o.transpose(1, 0, 3, 2, 4).reshape(b, lc, GDN_HEADS, GDN_DV)[:, pad_front:]
    z = z_raw.reshape(b, length, GDN_HEADS, GDN_DV).astype(jnp.float32)
    o = rmsnorm(o, gdn_norm) * jax.nn.silu(z)
    return o.reshape(b, length, GDN_HEADS * GDN_DV).astype(dtype)


def _w(k, shape, fan_in):
    return jax.random.normal(k, shape, jnp.float32) * (fan_in ** -0.5)


def _gain(k, shape):
    return 1.0 + 0.02 * jax.random.normal(k, shape, jnp.float32)


def setup_inputs(seed: int = 0) -> dict:
    key = jax.random.key(seed)
    ks = jax.random.split(key, 32)
    d = D_MODEL
    dt = jnp.exp(jax.random.uniform(ks[15], (DEPTH, GDN_HEADS), jnp.float32,
                                    minval=math.log(1e-3), maxval=math.log(1e-1)))
    return {
        'x': jax.random.normal(ks[0], (BATCH, SEQ, d), jnp.float32),
        'meta_tokens': jax.random.normal(ks[1], (N_META, d), jnp.float32),
        'ffn1_norm': _gain(ks[2], (DEPTH, d)),
        'ffn1_w_gate': _w(ks[3], (DEPTH, d, D_FF), d),
        'ffn1_w_up': _w(ks[4], (DEPTH, d, D_FF), d),
        'ffn1_w_down': _w(ks[5], (DEPTH, D_FF, d), D_FF),
        'mix_norm': _gain(ks[6], (DEPTH, d)),
        'w_in': _w(ks[7], (DEPTH, d, D_IN), d),
        'q_norm': _gain(ks[8], (DEPTH, MLA_Q_RANK)),
        'w_uq': _w(ks[9], (DEPTH, MLA_Q_RANK, MLA_HEADS * (MLA_NOPE + MLA_ROPE)), MLA_Q_RANK),
        'kv_norm': _gain(ks[10], (DEPTH, MLA_KV_RANK)),
        'w_ukv': _w(ks[11], (DEPTH, MLA_KV_RANK, MLA_HEADS * (MLA_NOPE + MLA_V)), MLA_KV_RANK),
        'w_mla_o': _w(ks[12], (DEPTH, MLA_HEADS * MLA_V, d), MLA_HEADS * MLA_V),
        'conv_w': _w(ks[13], (DEPTH, CONV_K, GDN_CONV_CH), CONV_K),
        'a_log': jnp.log(jax.random.uniform(ks[14], (DEPTH, GDN_HEADS), jnp.float32, minval=1.0, maxval=16.0)),
        'dt_bias': dt + jnp.log(-jnp.expm1(-dt)),
        'gdn_norm': _gain(ks[16], (DEPTH, GDN_DV)),
        'w_gdn_o': _w(ks[17], (DEPTH, GDN_HEADS * GDN_DV, d), GDN_HEADS * GDN_DV),
        'w_out': _w(ks[18], (DEPTH, d, d), d),
        'ffn2_norm': _gain(ks[19], (DEPTH, d)),
        'ffn2_w_gate': _w(ks[20], (DEPTH, d, D_FF), d),
        'ffn2_w_up': _w(ks[21], (DEPTH, d, D_FF), d),
        'ffn2_w_down': _w(ks[22], (DEPTH, D_FF, d), D_FF),
        'final_norm': _gain(ks[23], (d,)),
    }


def reference(x, meta_tokens, ffn1_norm, ffn1_w_gate, ffn1_w_up, ffn1_w_down, mix_norm, w_in,
              q_norm, w_uq, kv_norm, w_ukv, w_mla_o, conv_w, a_log, dt_bias, gdn_norm, w_gdn_o,
              w_out, ffn2_norm, ffn2_w_gate, ffn2_w_up, ffn2_w_down, final_norm):
    b = x.shape[0]
    meta = jnp.broadcast_to(meta_tokens[None].astype(x.dtype), (b, N_META, D_MODEL))
    h = jnp.concatenate([meta, x], axis=1)
    split_points = [int(p) for p in np.cumsum(SPLITS)[:-1]]
    for l in range(DEPTH):
        h = h + 0.5 * swiglu(rmsnorm(h, ffn1_norm[l]), ffn1_w_gate[l], ffn1_w_up[l], ffn1_w_down[l])
        u = rmsnorm(h, mix_norm[l])
        (c_q, c_kv, k_rope, g_q, g_k, g_v, g_b, g_a, g_z,
         gate_mla, gate_gdn) = jnp.split(u @ w_in[l], split_points, axis=-1)
        y_mla = mla(c_q, c_kv, k_rope, q_norm[l], w_uq[l], kv_norm[l], w_ukv[l]) @ w_mla_o[l]
        y_gdn = gated_deltanet(g_q, g_k, g_v, g_b, g_a, g_z, conv_w[l], a_log[l], dt_bias[l],
                               gdn_norm[l]) @ w_gdn_o[l]
        merged = jax.nn.sigmoid(gate_mla) * y_mla + jax.nn.sigmoid(gate_gdn) * y_gdn
        h = h + merged @ w_out[l]
        h = h + 0.5 * swiglu(rmsnorm(h, ffn2_norm[l]), ffn2_w_gate[l], ffn2_w_up[l], ffn2_w_down[l])
    return rmsnorm(h, final_norm)[:, N_META:]
```

```cpp
#include <hip/hip_runtime.h>
#include <hip/hip_cooperative_groups.h>
#include <stdint.h>
#include <stdio.h>
namespace cg = cooperative_groups;

#ifndef MULTI
#define MULTI 0
#endif

#define DI __device__ __forceinline__
typedef unsigned short u16;
typedef short bf16x8 __attribute__((ext_vector_type(8)));
typedef short s16x4 __attribute__((ext_vector_type(4)));
typedef float f32x16 __attribute__((ext_vector_type(16)));
typedef __bf16 bf2_t __attribute__((ext_vector_type(2)));
typedef float f2_t __attribute__((ext_vector_type(2)));

#define MFMA(a, b, c) __builtin_amdgcn_mfma_f32_32x32x16_bf16((a), (b), (c), 0, 0, 0)
#define MFMAF(a, b, c) __builtin_amdgcn_mfma_f32_32x32x2f32((a), (b), (c), 0, 0, 0)

constexpr int NB = 4, L = 4112, T = NB * L, MP = 16640, NRT = 65, LP = 4160;
constexpr int NTHR = 512, HALF_SMEM = 74240;
constexpr int NCH = 65, NJOBS = 32 * NCH;
constexpr int NATT = 33 * 32;
constexpr float EPS = 1e-6f;
constexpr float QSCALE = 0.10206207261596577f * 1.4426950408889634f;

constexpr size_t OFF_WGM = 0;
constexpr size_t OFF_WGG = OFF_WGM + (size_t)1024 * 1024 * 2;
constexpr size_t OFF_WUQ = OFF_WGG + (size_t)1024 * 1024 * 2;
constexpr size_t OFF_WUKV = OFF_WUQ + (size_t)768 * 256 * 2;
constexpr size_t OFF_WMO = OFF_WUKV + (size_t)1024 * 128 * 2;
constexpr size_t OFF_WGO = OFF_WMO + (size_t)1024 * 512 * 2;
constexpr size_t OFF_WOUT = OFF_WGO + (size_t)1024 * 512 * 2;
constexpr size_t OFF_WIN = OFF_WOUT + (size_t)1024 * 1024 * 2;
constexpr size_t OFF_SSQ0 = OFF_WIN + (size_t)2560 * 1024 * 2;
constexpr size_t SSQ_SZ = (size_t)MP * 16 * 4;
constexpr size_t OFF_SSQ1 = OFF_SSQ0 + SSQ_SZ;
constexpr size_t OFF_SSQ2 = OFF_SSQ1 + SSQ_SZ;
constexpr size_t OFF_SSQ3 = OFF_SSQ2 + SSQ_SZ;
constexpr size_t OFF_SSQQ = OFF_SSQ3 + SSQ_SZ;
constexpr size_t OFF_SSQKV = OFF_SSQQ + (size_t)MP * 4 * 4;
constexpr size_t OFF_SIDE = OFF_SSQKV + (size_t)MP * 2 * 4;
constexpr size_t OFF_ROPE = OFF_SIDE + (size_t)64 * 1024 * 4;
constexpr size_t OFF_BA = OFF_ROPE + (size_t)L * 16 * 2 * 4;
constexpr size_t OFF_DEC = OFF_BA + (size_t)MP * 16 * 4;
constexpr size_t OFF_CNT = OFF_DEC + (size_t)NJOBS * 4 + 192;
constexpr size_t OFF_BAR = OFF_CNT + 256;
constexpr size_t BAR_BYTES = 3456 * 4;
constexpr size_t OFF_SKC = OFF_BAR + BAR_BYTES;
constexpr size_t SKC_BYTES = 256;
constexpr size_t OFF_X = (OFF_SKC + SKC_BYTES + 255) & ~(size_t)255;
constexpr size_t X_SZ = (size_t)MP * 2816 * 2;
constexpr size_t OFF_PROJA = OFF_X;
constexpr size_t OFF_PROJZ = OFF_X + (size_t)MP * 2048 * 2;
constexpr size_t OFF_OMLA = OFF_X;
constexpr size_t OFF_OGDN = OFF_X + (size_t)MP * 512 * 2;
constexpr size_t OFF_HB1 = OFF_X + (size_t)MP * 1024 * 2;
constexpr size_t OFF_Y = OFF_X + X_SZ;
constexpr size_t Y_SZ = (size_t)NJOBS * 40960;
constexpr size_t OFF_W1T = OFF_Y;
constexpr size_t OFF_W2T = OFF_W1T + (size_t)5632 * 1024 * 2;
constexpr size_t OFF_HB = OFF_W2T + (size_t)1024 * 2816 * 2;
constexpr size_t OFF_Z = OFF_Y + Y_SZ;
constexpr size_t OFF_Q = OFF_Z;
constexpr size_t OFF_KN = OFF_Q + (size_t)MP * 768 * 2;
constexpr size_t OFF_VT = OFF_KN + (size_t)MP * 512 * 2;
constexpr size_t OFF_KR = OFF_VT + (size_t)NB * 8 * 64 * LP * 2;
constexpr size_t OFF_MERGED = OFF_Z;
constexpr size_t OFF_SPLITK = OFF_Z + (size_t)36 * 1024 * 1024;
constexpr size_t WS_TOTAL = OFF_KR + (size_t)MP * 32 * 2;
static_assert(OFF_HB + (size_t)MP * 1024 * 2 <= OFF_Z, "Y region overflow");
static_assert(OFF_PROJZ + (size_t)MP * 512 * 2 <= OFF_Y, "X region overflow");

constexpr int SMEM_BYTES = 148544;
constexpr int LDT = 72;
constexpr int STAGE = 2 * 256 * LDT;
constexpr int RS_OFF = 2 * STAGE * 2;

struct P {
  const float *x, *meta, *n1, *wg1, *wu1, *wd1, *nmix, *win, *qn, *wuq, *kvn, *wukv, *wmo, *convw, *alog, *dtb, *gdnn, *wgo, *wout, *n2, *wg2, *wu2, *wd2, *nf;
  float* out;
  unsigned char* ws;
};

#define WSP(type, off) ((type*)(p.ws + (off)))

DI int otid() { int t = threadIdx.x; asm volatile("" : "+v"(t)); return t; }
DI int obid() { int b = blockIdx.x; asm volatile("" : "+s"(b)); return b; }
DI unsigned pk2(float a, float b) {
  f2_t v = {a, b};
  bf2_t r = __builtin_convertvector(v, bf2_t);
  return __builtin_bit_cast(unsigned, r);
}
DI u16 f2bf(float a) { return (u16)(pk2(a, 0.f) & 0xffffu); }
DI float bf2f(u16 v) { return __uint_as_float(((unsigned)v) << 16); }
DI float fsilu(float x) { return x * __builtin_amdgcn_rcpf(1.f + __expf(-x)); }
DI float fsigmoid(float x) { return __builtin_amdgcn_rcpf(1.f + __expf(-x)); }

DI const float* xrow(const P& p, int r) {
  int b = r / L, t = r - b * L;
  return t < 16 ? p.meta + t * 1024 : p.x + (size_t)(b * 4096 + t - 16) * 1024;
}
DI float* hrow(const P& p, int r) {
  int b = r / L, t = r - b * L;
  return t < 16 ? WSP(float, OFF_SIDE) + (b * 16 + t) * 1024 : p.out + (size_t)(b * 4096 + t - 16) * 1024;
}

DI bf16x8 pack8(const f32x16& x, int s) {
  unsigned a = pk2(x[8 * s + 0], x[8 * s + 1]), b = pk2(x[8 * s + 2], x[8 * s + 3]);
  unsigned c = pk2(x[8 * s + 4], x[8 * s + 5]), d = pk2(x[8 * s + 6], x[8 * s + 7]);
  uint4 u = {a, b, c, d};
  return __builtin_bit_cast(bf16x8, u);
}
DI bf16x8 perm_read(const u16* m, int row, int ld, int ks, int hh) {
  const u16* q = m + row * ld + 16 * ks + 4 * hh;
  uint2 lo = *(const uint2*)q;
  uint2 hi = *(const uint2*)(q + 8);
  uint4 u = {lo.x, lo.y, hi.x, hi.y};
  return __builtin_bit_cast(bf16x8, u);
}

DI float row_reduce32(float (&v)[32], int lane) {
#pragma unroll
  for (int k = 0; k < 16; ++k) { bool up = lane & 16; float send = up ? v[k] : v[k + 16]; float keep = up ? v[k + 16] : v[k]; v[k] = keep + __shfl_xor(send, 16); }
#pragma unroll
  for (int k = 0; k < 8; ++k) { bool up = lane & 8; float send = up ? v[k] : v[k + 8]; float keep = up ? v[k + 8] : v[k]; v[k] = keep + __shfl_xor(send, 8); }
#pragma unroll
  for (int k = 0; k < 4; ++k) { bool up = lane & 4; float send = up ? v[k] : v[k + 4]; float keep = up ? v[k + 4] : v[k]; v[k] = keep + __shfl_xor(send, 4); }
#pragma unroll
  for (int k = 0; k < 2; ++k) { bool up = lane & 2; float send = up ? v[k] : v[k + 2]; float keep = up ? v[k + 2] : v[k]; v[k] = keep + __shfl_xor(send, 2); }
  { bool up = lane & 1; float send = up ? v[0] : v[1]; float keep = up ? v[1] : v[0]; v[0] = keep + __shfl_xor(send, 1); }
  return v[0];
}

struct RsReq { float* rs; const float* ssq; int nslots; float invn; };
DI void rs_part(const RsReq& q, int row0) {
  const int tid = threadIdx.x;
  if (tid < 256) {
    const float* s = q.ssq + (size_t)(row0 + tid) * q.nslots;
    float a = 0.f;
    if (q.nslots == 16) {
      const float4 v0 = *(const float4*)s, v1 = *(const float4*)(s + 4), v2 = *(const float4*)(s + 8), v3 = *(const float4*)(s + 12);
      a = ((v0.x + v0.y) + (v0.z + v0.w)) + ((v1.x + v1.y) + (v1.z + v1.w)) + ((v2.x + v2.y) + (v2.z + v2.w)) + ((v3.x + v3.y) + (v3.z + v3.w));
    } else if (q.nslots == 4) {
      const float4 v0 = *(const float4*)s;
      a = (v0.x + v0.y) + (v0.z + v0.w);
    } else {
      const float2 v0 = *(const float2*)s;
      a = v0.x + v0.y;
    }
    q.rs[tid] = rsqrtf(a * q.invn + EPS);
  }
}

template <int AMODE>
DI void gemm_accum(f32x16 (&acc)[4][2], u16* lds, const P& p, const u16* A, int lda, const float* normw,
                   const u16* Bt, int ldb, int K, int row0, int col0, RsReq rq = RsReq{nullptr, nullptr, 0, 0.f}) {
  int tid = threadIdx.x;
  asm volatile("" : "+v"(tid));
  const int lane = tid & 63, w = tid >> 6, wm = w >> 2, wn = w & 3, l32 = lane & 31, hh = lane >> 5;
  int nk = K >> 6;
  asm volatile("" : "+s"(nk));
  int mvalid = (T - (row0 + wm * 128) + 31) >> 5;
  mvalid = mvalid < 0 ? 0 : (mvalid > 4 ? 4 : mvalid);
  uint4 ra0, ra1, ra2, ra3, rb0, rb1, rb2, rb3;
  float4 fa0, fa1, fa2, fa3, fa4, fa5, fa6, fa7;
  float4 nw;
  const int ldr = tid >> 3, ldkc = tid & 7;
  const char* Abase = (const char*)(A + (size_t)row0 * lda);
  const char* Bbase = (const char*)(Bt + (size_t)col0 * ldb);
  const unsigned aoff = (unsigned)(ldr * lda + ldkc * 8) * 2u, astep = (unsigned)(64 * lda) * 2u;
  const unsigned boff = (unsigned)(ldr * ldb + ldkc * 8) * 2u, bstep = (unsigned)(64 * ldb) * 2u;
  const int fr = tid >> 4, fkc = tid & 15;
#define LA_(i) (*(const uint4*)(Abase + (size_t)kt__ * 128 + (aoff + (unsigned)(i) * astep)))
#define LB_(i) (*(const uint4*)(Bbase + (size_t)kt__ * 128 + (boff + (unsigned)(i) * bstep)))
#define LF_(i) (*(const float4*)(hrow(p, (row0 + fr + 32 * (i)) < T ? (row0 + fr + 32 * (i)) : T - 1) + kt__ * 64 + fkc * 4))
#define G_LOAD(kt_)                                                                                       \
  {                                                                                                       \
    const int kt__ = (kt_);                                                                               \
    if (AMODE == 0) { ra0 = LA_(0); ra1 = LA_(1); ra2 = LA_(2); ra3 = LA_(3); }                           \
    else {                                                                                                \
      fa0 = LF_(0); fa1 = LF_(1); fa2 = LF_(2); fa3 = LF_(3); fa4 = LF_(4); fa5 = LF_(5); fa6 = LF_(6); fa7 = LF_(7); \
      nw = *(const float4*)(normw + kt__ * 64 + fkc * 4);                                                 \
    }                                                                                                     \
    rb0 = LB_(0); rb1 = LB_(1); rb2 = LB_(2); rb3 = LB_(3);                                               \
  }
#define SA_(i, v) *(uint4*)(As_ + (ldr + 64 * (i)) * LDT + ldkc * 8) = (v)
#define SB_(i, v) *(uint4*)(Bs_ + (ldr + 64 * (i)) * LDT + ldkc * 8) = (v)
#define SF_(i, f) { uint2 v_ = {pk2((f).x * nw.x, (f).y * nw.y), pk2((f).z * nw.z, (f).w * nw.w)}; *(uint2*)(As_ + (fr + 32 * (i)) * LDT + fkc * 4) = v_; }
#define S_STORE(st_)                                                                                      \
  {                                                                                                       \
    u16* As_ = lds + (st_) * STAGE;                                                                       \
    u16* Bs_ = As_ + 256 * LDT;                                                                           \
    if (AMODE == 0) { SA_(0, ra0); SA_(1, ra1); SA_(2, ra2); SA_(3, ra3); }                               \
    else { SF_(0, fa0) SF_(1, fa1) SF_(2, fa2) SF_(3, fa3) SF_(4, fa4) SF_(5, fa5) SF_(6, fa6) SF_(7, fa7) } \
    SB_(0, rb0); SB_(1, rb1); SB_(2, rb2); SB_(3, rb3);                                                   \
  }
  asm volatile("" ::: "memory");
  __builtin_amdgcn_sched_barrier(0);
  if (AMODE == 1 || row0 + 256 <= T) {
#define PIECE_STORE(i, st_)                                                                               \
  {                                                                                                       \
    u16* As_ = lds + (st_) * STAGE;                                                                       \
    u16* Bs_ = As_ + 256 * LDT;                                                                           \
    if (AMODE == 0) {                                                                                     \
      if ((i) == 0) SA_(0, ra0); if ((i) == 1) SA_(1, ra1); if ((i) == 2) SA_(2, ra2); if ((i) == 3) SA_(3, ra3); \
      if ((i) == 4) SB_(0, rb0); if ((i) == 5) SB_(1, rb1); if ((i) == 6) SB_(2, rb2); if ((i) == 7) SB_(3, rb3); \
    } else {                                                                                              \
      if ((i) == 0) { SF_(0, fa0) SB_(0, rb0); } if ((i) == 1) { SF_(1, fa1) SB_(1, rb1); }               \
      if ((i) == 2) { SF_(2, fa2) SB_(2, rb2); } if ((i) == 3) { SF_(3, fa3) SB_(3, rb3); }               \
      if ((i) == 4) SF_(4, fa4) if ((i) == 5) SF_(5, fa5) if ((i) == 6) SF_(6, fa6) if ((i) == 7) SF_(7, fa7) \
    }                                                                                                     \
  }
#define PIECE_LOAD(i, kt_)                                                                                \
  {                                                                                                       \
    const int kt__ = (kt_);                                                                               \
    if (AMODE == 0) {                                                                                     \
      if ((i) == 0) ra0 = LA_(0); if ((i) == 1) ra1 = LA_(1); if ((i) == 2) ra2 = LA_(2); if ((i) == 3) ra3 = LA_(3); \
      if ((i) == 4) rb0 = LB_(0); if ((i) == 5) rb1 = LB_(1); if ((i) == 6) rb2 = LB_(2); if ((i) == 7) rb3 = LB_(3); \
    } else {                                                                                              \
      if ((i) == 0) { fa0 = LF_(0); rb0 = LB_(0); } if ((i) == 1) { fa1 = LF_(1); rb1 = LB_(1); }         \
      if ((i) == 2) { fa2 = LF_(2); rb2 = LB_(2); } if ((i) == 3) { fa3 = LF_(3); rb3 = LB_(3); }         \
      if ((i) == 4) fa4 = LF_(4); if ((i) == 5) fa5 = LF_(5); if ((i) == 6) fa6 = LF_(6);                 \
      if ((i) == 7) { fa7 = LF_(7); nw = *(const float4*)(normw + kt__ * 64 + fkc * 4); }                 \
    }                                                                                                     \
  }
#define K_PIPE_PRO                                                                                       \
    G_LOAD(0);                                                                                            \
    if (rq.rs) rs_part(rq, row0);                                                                         \
    S_STORE(0);                                                                                           \
    G_LOAD(nk > 1 ? 1 : 0);                                                                               \
    __syncthreads();                                                                                      \
    int kt = 0;
#define K_BODY(HFN, DOLOAD)                                                                               \
    {                                                                                                     \
      const u16* As = lds + (kt & 1) * STAGE;                                                             \
      const u16* Bs = As + 256 * LDT;                                                                     \
      const u16* ap = As + (wm * 128 + l32) * LDT + hh * 8;                                               \
      const u16* bp = Bs + (wn * 64 + l32) * LDT + hh * 8;                                                \
      const int nst = (kt + 1) & 1;                                                                       \
      const int ktn = kt + 2 < nk ? kt + 2 : nk - 1;                                                      \
      bf16x8 af[2][2], bq[2][2];                                                                          \
      bq[0][0] = *(const bf16x8*)(bp);                                                                    \
      bq[0][1] = *(const bf16x8*)(bp + 32 * LDT);                                                         \
      af[0][0] = *(const bf16x8*)(ap);                                                                    \
      af[0][1] = *(const bf16x8*)(ap + 32 * LDT);                                                         \
      _Pragma("unroll") for (int sq = 0; sq < 4 * (HFN); ++sq) {                                          \
        const int st = (HFN) == 2 ? sq : 2 * sq;                                  \
        const int ks = st >> 1, hf = st & 1, cur = sq & 1, nxt = cur ^ 1;                                 \
        if (sq + 1 < 4 * (HFN)) {                                                                         \
          const int st2 = (HFN) == 2 ? sq + 1 : 2 * (sq + 1);                                             \
          const int ks2 = st2 >> 1, hf2 = st2 & 1;                                                        \
          af[nxt][0] = *(const bf16x8*)(ap + (hf2 * 2 + 0) * 32 * LDT + ks2 * 16);                        \
          af[nxt][1] = *(const bf16x8*)(ap + (hf2 * 2 + 1) * 32 * LDT + ks2 * 16);                        \
          if (hf2 == 0) {                                                                                 \
            bq[ks2 & 1][0] = *(const bf16x8*)(bp + ks2 * 16);                                             \
            bq[ks2 & 1][1] = *(const bf16x8*)(bp + 32 * LDT + ks2 * 16);                                  \
          }                                                                                               \
        }                                                                                                 \
        if ((HFN) == 2) { PIECE_STORE(sq, nst) if (DOLOAD) PIECE_LOAD(sq, ktn) }                          \
        else { PIECE_STORE(2 * sq, nst) PIECE_STORE(2 * sq + 1, nst) if (DOLOAD) { PIECE_LOAD(2 * sq, ktn) PIECE_LOAD(2 * sq + 1, ktn) } } \
        acc[hf * 2 + 0][0] = MFMA(af[cur][0], bq[ks & 1][0], acc[hf * 2 + 0][0]);                         \
        acc[hf * 2 + 0][1] = MFMA(af[cur][0], bq[ks & 1][1], acc[hf * 2 + 0][1]);                         \
        acc[hf * 2 + 1][0] = MFMA(af[cur][1], bq[ks & 1][0], acc[hf * 2 + 1][0]);                         \
        acc[hf * 2 + 1][1] = MFMA(af[cur][1], bq[ks & 1][1], acc[hf * 2 + 1][1]);                         \
        __builtin_amdgcn_sched_barrier(0);                                                                \
      }                                                                                                   \
      __syncthreads();                                                                                    \
    }
#define K_PIPE(HFN) K_PIPE_PRO for (; kt < nk - 2; ++kt) K_BODY(HFN, 1) for (; kt < nk; ++kt) K_BODY(HFN, 0)
    K_PIPE(2)
  } else {
    K_PIPE(1)
  }
#undef K_PIPE
#undef K_PIPE_PRO
#undef K_BODY
#undef PIECE_STORE
#undef PIECE_LOAD
  asm volatile("" ::: "memory");
  __builtin_amdgcn_sched_barrier(0);
#undef G_LOAD
#undef S_STORE
#undef LA_
#undef LB_
#undef LF_
#undef SA_
#undef SB_
#undef SF_
}

DI void zero_acc(f32x16 (&acc)[4][2]) {
#pragma unroll
  for (int i = 0; i < 4; ++i)
#pragma unroll
    for (int j = 0; j < 2; ++j)
#pragma unroll
      for (int r = 0; r < 16; ++r) acc[i][j][r] = 0.f;
}

#define EPI_SETUP
#define TILE_SETUP int tid_ = threadIdx.x; asm volatile("" : "+v"(tid_)); const int lane = tid_ & 63, w = tid_ >> 6, wm = w >> 2, wn = w & 3, l32 = lane & 31, hh = lane >> 5; (void)wn; (void)l32; (void)lane; (void)wm; (void)hh;
#define LROW(mt, r) (wm * 128 + (mt) * 32 + 8 * ((r) >> 2) + 4 * hh + ((r) & 3))

DI void tile_map(int it, int nct, int& rt, int& ct) {
  const int G = gridDim.x, k = it / G, b = it - k * G;
  const int per = G >> 3;
  const int o = ((G & 7) == 0 && (k + 1) * G <= 65 * nct) ? k * G + (b & 7) * per + (b >> 3) : it;
  const int nmain = 64 * nct;
  if (o >= nmain) { rt = 64; ct = o - nmain; return; }
  const int pw = 8 * 64;
  const int pnl = o / pw, w = (nct - pnl * 8) < 8 ? (nct - pnl * 8) : 8;
  const int oo = o - pnl * pw;
  rt = oo / w;
  ct = pnl * 8 + (oo - rt * w);
}

struct TrDesc { const float* src; int ldw; int K; int nvalid; int nk; int nn; u16* dst; int mode; };
DI int tr_drow(int n, int mode) {
  if (mode == 0) return n;
  return 128 * (n >> 6) + 64 * ((n & 63) >> 5) + 32 * (mode - 1) + (n & 31);
}
DI bool tr_try(int& it, const TrDesc& d, float* ts) {
  const int n = d.nk * d.nn;
  if (it >= n) { it -= n; return false; }
  const int kt = it % d.nk, nt = it / d.nk, k0 = kt * 64, n0 = nt * 64, tid = otid() & 255;
  __syncthreads();
  {
    float tv[16];
    const int nn = tid & 63, nc = n0 + nn;
#pragma unroll
    for (int i = 0; i < 16; ++i) { const int kk = i * 4 + (tid >> 6); tv[i] = nc < d.nvalid ? d.src[(size_t)(k0 + kk) * d.ldw + nc] : 0.f; }
#pragma unroll
    for (int i = 0; i < 16; ++i) { const int kk = i * 4 + (tid >> 6); ts[kk * 65 + nn] = tv[i]; }
  }
  __syncthreads();
#pragma unroll
  for (int i = 0; i < 2; ++i) {
    const int idx = tid + 256 * i, nn = idx >> 3, c = idx & 7;
    float e[8];
#pragma unroll
    for (int j = 0; j < 8; ++j) e[j] = ts[(c * 8 + j) * 65 + nn];
    uint4 o = {pk2(e[0], e[1]), pk2(e[2], e[3]), pk2(e[4], e[5]), pk2(e[6], e[7])};
    *(uint4*)(d.dst + (size_t)tr_drow(n0 + nn, d.mode) * d.K + k0 + c * 8) = o;
  }
  return true;
}

DI void phase0(const P& p, unsigned char* smem) {
  const int tid = otid(), lane = tid & 63, w = tid >> 6, half = (__builtin_amdgcn_readfirstlane(tid >> 8) & 1);
  const int bid = obid();
  float* ts = (float*)(smem + half * HALF_SMEM);
  const int NT0 = 704 * 3 + 640 + 256 * 2 + 48 + 32 + 128 * 2 + 256;
  for (int ip = bid; ip < NT0 / 2; ip += gridDim.x) {
    int it = 2 * ip + half;
    if (tr_try(it, TrDesc{p.wg1, 2816, 1024, 2816, 16, 44, WSP(u16, OFF_W1T), 1}, ts)) continue;
    if (tr_try(it, TrDesc{p.wu1, 2816, 1024, 2816, 16, 44, WSP(u16, OFF_W1T), 2}, ts)) continue;
    if (tr_try(it, TrDesc{p.wd1, 1024, 2816, 1024, 44, 16, WSP(u16, OFF_W2T), 0}, ts)) continue;
    if (tr_try(it, TrDesc{p.win, 4528, 1024, 2480, 16, 40, WSP(u16, OFF_WIN), 0}, ts)) continue;
    if (tr_try(it, TrDesc{p.win + 2480, 4528, 1024, 1024, 16, 16, WSP(u16, OFF_WGM), 0}, ts)) continue;
    if (tr_try(it, TrDesc{p.win + 3504, 4528, 1024, 1024, 16, 16, WSP(u16, OFF_WGG), 0}, ts)) continue;
    if (tr_try(it, TrDesc{p.wuq, 768, 256, 768, 4, 12, WSP(u16, OFF_WUQ), 0}, ts)) continue;
    if (tr_try(it, TrDesc{p.wukv, 1024, 128, 1024, 2, 16, WSP(u16, OFF_WUKV), 0}, ts)) continue;
    if (tr_try(it, TrDesc{p.wmo, 1024, 512, 1024, 8, 16, WSP(u16, OFF_WMO), 0}, ts)) continue;
    if (tr_try(it, TrDesc{p.wgo, 1024, 512, 1024, 8, 16, WSP(u16, OFF_WGO), 0}, ts)) continue;
    if (tr_try(it, TrDesc{p.wout, 1024, 1024, 1024, 16, 16, WSP(u16, OFF_WOUT), 0}, ts)) continue;
  }
  u16* hb = WSP(u16, OFF_HB);
  float* ssq0 = WSP(float, OFF_SSQ0);
  {
    float4 g4[4];
#pragma unroll
    for (int i = 0; i < 4; ++i) g4[i] = *(const float4*)(p.n1 + lane * 4 + 256 * i);
    for (int r0 = (bid * 8 + w) * 4; r0 < T; r0 += gridDim.x * 8 * 4) {
      float4 v[4][4];
#pragma unroll
      for (int q = 0; q < 4; ++q) {
        const float* src = xrow(p, r0 + q);
#pragma unroll
        for (int i = 0; i < 4; ++i) v[q][i] = *(const float4*)(src + lane * 4 + 256 * i);
      }
#pragma unroll
      for (int q = 0; q < 4; ++q) {
        float ss = 0.f;
#pragma unroll
        for (int i = 0; i < 4; ++i) {
          const float4 x4 = v[q][i];
          ss += x4.x * x4.x + x4.y * x4.y + x4.z * x4.z + x4.w * x4.w;
          uint2 o = {pk2(x4.x * g4[i].x, x4.y * g4[i].y), pk2(x4.z * g4[i].z, x4.w * g4[i].w)};
          *(uint2*)(hb + (size_t)(r0 + q) * 1024 + lane * 4 + 256 * i) = o;
        }
#pragma unroll
        for (int m = 32; m >= 1; m >>= 1) ss += __shfl_xor(ss, m);
        if (lane < 16) ssq0[(size_t)(r0 + q) * 16 + lane] = lane == 0 ? ss : 0.f;
      }
    }
  }
  float* cosT = WSP(float, OFF_ROPE);
  float* sinT = cosT + L * 16;
  for (int idx = bid * NTHR + tid; idx < L * 16; idx += gridDim.x * NTHR) {
    int pos = idx >> 4, i = idx & 15;
    double inv = 1.0;
    const double rr = 0.5623413251903491;
    for (int j = 0; j < i; ++j) inv *= rr;
    float ang = (float)pos * (float)inv;
    double q = (double)ang * 0.15915494309189535;
    q -= __builtin_rint(q);
    float fr = (float)q;
    ((float2*)cosT)[idx] = make_float2(__builtin_amdgcn_cosf(fr), __builtin_amdgcn_sinf(fr));
    (void)sinT;
  }
  if (bid == 0 && tid == 0) *WSP(int, OFF_CNT) = 0;
}

DI void phase_gateup(const P& p, unsigned char* smem, const u16* Wt, const float* ssq) {
  u16* lds = (u16*)smem;
  float* rs = (float*)(smem + RS_OFF);
  const u16* hb = WSP(u16, OFF_HB);
  u16* act = WSP(u16, OFF_X);
  for (int tile = blockIdx.x; tile < NRT * 22; tile += gridDim.x) {
    int rt, ct;
    tile_map(tile, 22, rt, ct);
    const int row0 = rt * 256, col0 = ct * 256;
    __syncthreads();
    f32x16 acc[4][2];
    zero_acc(acc);
    gemm_accum<0>(acc, lds, p, hb, 1024, nullptr, Wt, 1024, 1024, row0, col0, RsReq{rs, ssq, 16, 1.f / 1024.f});
    TILE_SETUP
#pragma unroll
    for (int mt = 0; mt < 4; ++mt)
#pragma unroll
      for (int r = 0; r < 16; ++r) {
        const int lr = LROW(mt, r), row = row0 + lr;
        const float s = rs[lr];
        const float g = acc[mt][0][r] * s, u = acc[mt][1][r] * s;
        act[(unsigned)(row * 2816 + ct * 128 + wn * 32 + l32)] = f2bf(fsilu(g) * u);
        if ((r & 3) == 3) asm volatile("" ::: "memory");
      }
  }
}

DI bool splitk_combine(f32x16 (&acc)[4][2], float* part, unsigned* cnt, int S, int sp, int ct, int* sflag) {
  int tid = threadIdx.x;
  asm volatile("" : "+v"(tid));
  float* base = part + (size_t)ct * S * 32768;
  float* mine = base + (size_t)sp * 32768 + tid;
#pragma unroll
  for (int mt = 0; mt < 2; ++mt)
#pragma unroll
    for (int nt = 0; nt < 2; ++nt)
#pragma unroll
      for (int r = 0; r < 16; ++r) mine[((mt * 2 + nt) * 16 + r) * 512] = acc[mt][nt][r];
  asm volatile("s_waitcnt vmcnt(0)" ::: "memory");
  __syncthreads();
  if (threadIdx.x == 0) {
    __threadfence();
    asm volatile("s_waitcnt vmcnt(0)" ::: "memory");
    const unsigned t = __hip_atomic_fetch_add(cnt + ct, 1u, __ATOMIC_RELAXED, __HIP_MEMORY_SCOPE_AGENT);
    const int last = t == (unsigned)(S - 1);
    if (last) { __threadfence(); asm volatile("s_waitcnt vmcnt(0)" ::: "memory"); }
    *sflag = last;
  }
  __syncthreads();
  if (!*sflag) return false;
  for (int s2 = 0; s2 < S; ++s2) {
    if (s2 == sp) continue;
    const float* o = base + (size_t)s2 * 32768 + tid;
#pragma unroll
    for (int mt = 0; mt < 2; ++mt)
#pragma unroll
      for (int nt = 0; nt < 2; ++nt)
#pragma unroll
        for (int r = 0; r < 16; ++r) acc[mt][nt][r] += o[((mt * 2 + nt) * 16 + r) * 512];
  }
  return true;
}

template <int MODE>
DI void phase_resid(const P& p, unsigned char* smem) {
  u16* lds = (u16*)smem;
  const u16* A = MODE == 1 ? WSP(u16, OFF_MERGED) : WSP(u16, OFF_X);
  const int K = MODE == 1 ? 1024 : 2816;
  const u16* Wt = MODE == 0 ? WSP(u16, OFF_W2T) : (MODE == 1 ? WSP(u16, OFF_WOUT) : WSP(u16, OFF_W2T));
  float* ssq = MODE == 0 ? WSP(float, OFF_SSQ1) : (MODE == 1 ? WSP(float, OFF_SSQ2) : WSP(float, OFF_SSQ3));
  const float scale = MODE == 1 ? 1.f : 0.5f;
  u16* hb = WSP(u16, OFF_HB);
  const int SPL = K / 256;
  unsigned* skc = WSP(unsigned, OFF_SKC) + MODE * 4;
  float* part = WSP(float, OFF_SPLITK);
  int* sflag = (int*)(smem + RS_OFF);
  for (int tile = blockIdx.x; tile < 256 + 4 * SPL; tile += gridDim.x) {
    int rt, ct, sp = -1;
    if (tile < 256) tile_map(tile, 4, rt, ct);
    else { rt = 64; ct = (tile - 256) & 3; sp = (tile - 256) >> 2; }
    const int row0 = rt * 256, col0 = ct * 256;
    f32x16 acc[4][2];
    zero_acc(acc);
    if (sp < 0) gemm_accum<0>(acc, lds, p, A, K, nullptr, Wt, K, K, row0, col0);
    else {
      gemm_accum<0>(acc, lds, p, A + sp * 256, K, nullptr, Wt + sp * 256, K, 256, row0, col0);
      if (!splitk_combine(acc, part, skc, SPL, sp, ct, sflag)) continue;
    }
    TILE_SETUP
#pragma unroll
    for (int mp = 0; mp < 2; ++mp) {
      float v[32];
#pragma unroll
      for (int m2 = 0; m2 < 2; ++m2) {
        const int mt = mp * 2 + m2;
        float sv[16][2];
#pragma unroll
        for (int r = 0; r < 16; ++r) {
          const int row = row0 + LROW(mt, r);
          const int rc = row < T ? row : T - 1;
          const float* src = MODE == 0 ? xrow(p, rc) : hrow(p, rc);
          sv[r][0] = src[col0 + wn * 64 + l32];
          sv[r][1] = src[col0 + wn * 64 + 32 + l32];
        }
        asm volatile("" ::: "memory");
#pragma unroll
        for (int r = 0; r < 16; ++r) {
          const int row = row0 + LROW(mt, r);
          const bool ok = row < T;
          const int rc = ok ? row : T - 1;
          float* dst = hrow(p, rc);
          float sq = 0.f;
#pragma unroll
          for (int nt = 0; nt < 2; ++nt) {
            const int col = col0 + wn * 64 + nt * 32 + l32;
            const float hv = sv[r][nt] + scale * acc[mt][nt][r];
            if (ok) {
              dst[col] = hv;
              if (MODE <= 1) hb[(size_t)row * 1024 + col] = f2bf(hv * (MODE == 0 ? p.nmix : p.n2)[col]);
            }
            sq += hv * hv;
          }
          v[m2 * 16 + r] = sq;
          if ((r & 3) == 3) asm volatile("" ::: "memory");
        }
      }
      const float tot = row_reduce32(v, lane);
      const int idx = lane & 31;
      const int row = row0 + wm * 128 + (mp * 2 + (idx >> 4)) * 32 + 8 * ((idx & 15) >> 2) + 4 * hh + (idx & 3);
      ssq[(size_t)row * 16 + ct * 4 + wn] = tot;
    }
  }
}

DI float rope_val(float val, int l32, int pos, const float* cosT, const float* sinT) {
  const float partner = __shfl_xor(val, 16);
  const int i = l32 & 15;
  const float2 cs2 = ((const float2*)cosT)[pos * 16 + i];
  const float cs = cs2.x, sn = cs2.y;
  (void)sinT;
  return l32 < 16 ? val * cs - partner * sn : val * cs + partner * sn;
}

DI void phase_inproj(const P& p, unsigned char* smem) {
  u16* lds = (u16*)smem;
  float* rs = (float*)(smem + RS_OFF);
  u16* projA = WSP(u16, OFF_PROJA);
  u16* projZ = WSP(u16, OFF_PROJZ);
  u16* kr = WSP(u16, OFF_KR);
  float* ba = WSP(float, OFF_BA);
  const float* cosT = WSP(float, OFF_ROPE);
  const float* sinT = cosT + L * 16;
  for (int tile = blockIdx.x; tile < NRT * 10; tile += gridDim.x) {
    int rt, ct;
    tile_map(tile, 10, rt, ct);
    const int row0 = rt * 256, col0 = ct * 256;
    __syncthreads();
    f32x16 acc[4][2];
    zero_acc(acc);
    gemm_accum<0>(acc, lds, p, WSP(u16, OFF_HB), 1024, nullptr, WSP(u16, OFF_WIN), 1024, 1024, row0, col0, RsReq{rs, WSP(float, OFF_SSQ1), 16, 1.f / 1024.f});
    TILE_SETUP
    const int g64 = ct * 4 + wn;
    if (g64 <= 5) {
      const float* nwp = g64 < 4 ? p.qn + g64 * 64 : p.kvn + (g64 - 4) * 64;
#pragma unroll
      for (int mp = 0; mp < 2; ++mp) {
        float v[32];
#pragma unroll
        for (int m2 = 0; m2 < 2; ++m2)
#pragma unroll
          for (int r = 0; r < 16; ++r) {
            const int mt = mp * 2 + m2;
            const int lr = LROW(mt, r), row = row0 + lr;
            const float sc = rs[lr];
            float sq = 0.f;
#pragma unroll
            for (int nt = 0; nt < 2; ++nt) {
              const int lc = nt * 32 + l32;
              const float val = acc[mt][nt][r] * sc;
              projA[(unsigned)(row * 2048 + g64 * 64 + lc)] = f2bf(val * nwp[lc]);
              sq += val * val;
            }
            v[m2 * 16 + r] = sq;
          }
        const float tot = row_reduce32(v, lane);
        const int idx = lane & 31;
        const int row = row0 + wm * 128 + (mp * 2 + (idx >> 4)) * 32 + 8 * ((idx & 15) >> 2) + 4 * hh + (idx & 3);
        if (g64 < 4) WSP(float, OFF_SSQQ)[(size_t)row * 4 + g64] = tot;
        else WSP(float, OFF_SSQKV)[(size_t)row * 2 + (g64 - 4)] = tot;
      }
    } else {
#pragma unroll
      for (int nt = 0; nt < 2; ++nt) {
        const int cb = g64 * 64 + nt * 32, col = cb + l32;
        if (cb == 384) {
#pragma unroll
          for (int mt = 0; mt < 4; ++mt)
#pragma unroll
            for (int r = 0; r < 16; ++r) {
              const int lr = LROW(mt, r), row = row0 + lr;
              const int rc = row < T ? row : T - 1;
              const float val = acc[mt][nt][r] * rs[lr];
              const float o = rope_val(val, l32, rc % L, cosT, sinT);
              kr[(unsigned)(row * 32 + l32)] = f2bf(o);
              if (r == 15) asm volatile("" ::: "memory");
            }
        } else {
#pragma unroll
          for (int mt = 0; mt < 4; ++mt)
#pragma unroll
            for (int r = 0; r < 16; ++r) {
              const int lr = LROW(mt, r), row = row0 + lr;
              const float val = acc[mt][nt][r] * rs[lr];
              if (col < 1952) projA[(unsigned)(row * 2048 + col)] = f2bf(val);
              else if (col < 1968) ba[(unsigned)(row * 16 + col - 1952)] = val;
              else if (col < 2480) projZ[(unsigned)(row * 512 + col - 1968)] = f2bf(val);
              if ((r & 3) == 3) asm volatile("" ::: "memory");
            }
        }
      }
    }
  }
}

DI void up_q_tile(const P& p, unsigned char* smem, int tile) {
  u16* lds = (u16*)smem;
  float* rs = (float*)(smem + RS_OFF);
  const int ct = tile % 3, rt = tile / 3, row0 = rt * 256, col0 = ct * 256;
  const float* cosT = WSP(float, OFF_ROPE);
  const float* sinT = cosT + L * 16;
  u16* qb = WSP(u16, OFF_Q);
  __syncthreads();
  f32x16 acc[4][2];
  zero_acc(acc);
  gemm_accum<0>(acc, lds, p, WSP(u16, OFF_PROJA), 2048, nullptr, WSP(u16, OFF_WUQ), 256, 256, row0, col0, RsReq{rs, WSP(float, OFF_SSQQ), 4, 1.f / 256.f});
  TILE_SETUP
  const int rb = row0 + wm * 128 + 4 * hh;
  const int rbc = rb < T ? rb : T - 1;
  const int pos0 = rbc % L;
#pragma unroll
  for (int nt = 0; nt < 2; ++nt) {
    const int cb = col0 + wn * 64 + nt * 32, col = cb + l32;
    const bool isrope = ((cb >> 5) % 3) == 2;
    if (isrope) {
      int pm = pos0;
#pragma unroll
      for (int mt = 0; mt < 4; ++mt) {
        int pg = pm;
#pragma unroll
        for (int g = 0; g < 4; ++g) {
#pragma unroll
          for (int e = 0; e < 4; ++e) {
            const int r = 4 * g + e;
            const int lr = LROW(mt, r), row = row0 + lr;
            int pos = pg + e;
            pos = pos >= L ? pos - L : pos;
            const float val = rope_val(acc[mt][nt][r] * rs[lr], l32, pos, cosT, sinT);
            qb[(unsigned)(row * 768 + col)] = f2bf(val * QSCALE);
          }
          asm volatile("" ::: "memory");
          __builtin_amdgcn_sched_barrier(0);
          pg += 8;
          pg = pg >= L ? pg - L : pg;
        }
        pm += 32;
        pm = pm >= L ? pm - L : pm;
      }
    } else {
#pragma unroll
      for (int mt = 0; mt < 4; ++mt)
#pragma unroll
        for (int r = 0; r < 16; ++r) {
          const int lr = LROW(mt, r), row = row0 + lr;
          qb[(unsigned)(row * 768 + col)] = f2bf(acc[mt][nt][r] * rs[lr] * QSCALE);
          if ((r & 3) == 3) { asm volatile("" ::: "memory"); __builtin_amdgcn_sched_barrier(0); }
        }
    }
  }
}
DI void up_kv_tile(const P& p, unsigned char* smem, int tile) {
  u16* lds = (u16*)smem;
  float* rs = (float*)(smem + RS_OFF);
  const int ct = tile % 4, rt = tile / 4, row0 = rt * 256, col0 = ct * 256;
  u16* kn = WSP(u16, OFF_KN);
  u16* vt = WSP(u16, OFF_VT);
  __syncthreads();
  f32x16 acc[4][2];
  zero_acc(acc);
  gemm_accum<0>(acc, lds, p, WSP(u16, OFF_PROJA) + 256, 2048, nullptr, WSP(u16, OFF_WUKV), 128, 128, row0, col0, RsReq{rs, WSP(float, OFF_SSQKV), 2, 1.f / 128.f});
  TILE_SETUP
  const int g64 = ct * 4 + wn, head = g64 >> 1;
  if ((g64 & 1) == 0) {
#pragma unroll
    for (int nt = 0; nt < 2; ++nt)
#pragma unroll
      for (int mt = 0; mt < 4; ++mt)
#pragma unroll
        for (int r = 0; r < 16; ++r) {
          const int lr = LROW(mt, r), row = row0 + lr;
          kn[(unsigned)(row * 512 + head * 64 + nt * 32 + l32)] = f2bf(acc[mt][nt][r] * rs[lr]);
          if ((r & 3) == 3) { asm volatile("" ::: "memory"); __builtin_amdgcn_sched_barrier(0); }
        }
  } else {
    const int rbase = row0 + wm * 128 + 4 * hh;
    const int b0 = rbase / L, bnd = (b0 + 1) * L;
    u16* vbase = vt + (size_t)(head * 64 + l32) * LP;
#pragma unroll
    for (int nt = 0; nt < 2; ++nt)
#pragma unroll
      for (int mt = 0; mt < 4; ++mt)
#pragma unroll
        for (int g = 0; g < 4; ++g) {
          const int row = rbase + mt * 32 + 8 * g, lr = row - row0;
          if (row < T) {
            const int b = row >= bnd ? b0 + 1 : b0, t = row - b * L;
            const unsigned off = (unsigned)((b * 512 + nt * 32) * LP + t);
            uint2 o = {pk2(acc[mt][nt][4 * g] * rs[lr], acc[mt][nt][4 * g + 1] * rs[lr + 1]),
                       pk2(acc[mt][nt][4 * g + 2] * rs[lr + 2], acc[mt][nt][4 * g + 3] * rs[lr + 3])};
            *(uint2*)(vbase + off) = o;
          }
          asm volatile("" ::: "memory");
          __builtin_amdgcn_sched_barrier(0);
        }
  }
}

DI void gdn_prep(const P& p, unsigned char* smem, int job) {
  const int tid = threadIdx.x, lane = tid & 63, w = tid >> 6, l32 = lane & 31, hh = lane >> 5;
  const int n = job % NCH, bh = job / NCH, hd = bh & 7, b = bh >> 3;
  float* qs = (float*)smem;
  float* ks = qs + 64 * 65;
  float* vs = ks + 64 * 65;
  float* Ls = vs + 64 * 65;
  float* gcs = Ls + 4096;
  float* betas = gcs + 64;
  float* egs = betas + 64;
  const u16* projA = WSP(u16, OFF_PROJA);
  const float* ba = WSP(float, OFF_BA);
  u16* cbase = WSP(u16, OFF_Y) + (size_t)job * 20480;
  u16* uT = cbase;
  u16* wnm = cbase + 4096;
  u16* qg = cbase + 8192;
  u16* intra = cbase + 12288;
  u16* kdT = cbase + 16384;
  const int t0 = 64 * n - 48;
  __syncthreads();
  {
    const int d = tid & 63, tg = tid >> 6;
    const int tb = t0 + tg * 8;
#pragma unroll
    for (int part = 0; part < 3; ++part) {
      const int ch = part * 512 + hd * 64 + d;
      const int col = 416 + ch;
      const float w0 = p.convw[ch], w1 = p.convw[1536 + ch], w2 = p.convw[2 * 1536 + ch], w3 = p.convw[3 * 1536 + ch];
      float* dst = part == 0 ? qs : (part == 1 ? ks : vs);
      auto ld = [&](int t) __attribute__((always_inline)) -> float { const float v_ = bf2f(projA[(size_t)(b * L + (t >= 0 ? t : 0)) * 2048 + col]); return t >= 0 ? v_ : 0.f; };
      float x0 = ld(tb - 3), x1 = ld(tb - 2), x2 = ld(tb - 1);
#pragma unroll
      for (int c = 0; c < 8; ++c) {
        const int t = tb + c;
        const float x3 = ld(t);
        const float y = w0 * x0 + w1 * x1 + w2 * x2 + w3 * x3;
        dst[(tg * 8 + c) * 65 + d] = t >= 0 ? fsilu(y) : 0.f;
        x0 = x1; x1 = x2; x2 = x3;
      }
    }
  }
  if (tid < 64) {
    const int t = t0 + tid;
    float beta = 0.f, g = 0.f;
    if (t >= 0) {
      const size_t row = (size_t)(b * L + t);
      const float braw = ba[row * 16 + hd], araw = ba[row * 16 + 8 + hd];
      beta = fsigmoid(braw);
      const float xx = araw + p.dtb[hd];
      const float sp = xx > 20.f ? xx : __logf(1.f + __expf(xx));
      g = -__expf(p.alog[hd]) * sp;
    }
    float gc = g;
#pragma unroll
    for (int off = 1; off < 64; off <<= 1) { float o = __shfl_up(gc, off); if (lane >= off) gc += o; }
    gcs[tid] = gc;
    betas[tid] = beta;
    egs[tid] = __expf(gc);
  }
  __syncthreads();
  if (tid < 256) {
    const int row = tid >> 2, q4 = tid & 3;
    float sq = 0.f, sk = 0.f;
#pragma unroll
    for (int j = 0; j < 16; ++j) { float a = qs[row * 65 + q4 * 16 + j], c = ks[row * 65 + q4 * 16 + j]; sq += a * a; sk += c * c; }
    sq += __shfl_xor(sq, 1); sq += __shfl_xor(sq, 2);
    sk += __shfl_xor(sk, 1); sk += __shfl_xor(sk, 2);
    const float fq = rsqrtf(sq + EPS) * 0.125f, fk = rsqrtf(sk + EPS);
#pragma unroll
    for (int j = 0; j < 16; ++j) { qs[row * 65 + q4 * 16 + j] *= fq; ks[row * 65 + q4 * 16 + j] *= fk; }
  }
  __syncthreads();
  {
    const int prod = w >> 2, mi = (w >> 1) & 1, ni = w & 1;
    f32x16 am;
#pragma unroll
    for (int r = 0; r < 16; ++r) am[r] = 0.f;
    if (!(mi == 0 && ni == 1)) {
      const float* ar_ = (prod == 0 ? ks : qs) + (32 * mi + l32) * 65 + hh;
      const float* kc_ = ks + (32 * ni + l32) * 65 + hh;
#pragma unroll 8
      for (int s2 = 0; s2 < 32; ++s2) am = MFMAF(ar_[2 * s2], kc_[2 * s2], am);
    }
#pragma unroll
    for (int r = 0; r < 16; ++r) {
      const int i = 32 * mi + 8 * (r >> 2) + 4 * hh + (r & 3), j = 32 * ni + l32;
      const float dec = i >= j ? __expf(gcs[i] - gcs[j]) : 0.f;
      if (prod == 0) Ls[i * 64 + j] = i > j ? am[r] * betas[i] * dec : 0.f;
      else intra[i * 64 + j] = f2bf(i >= j ? am[r] * dec : 0.f);
    }
  }
  __syncthreads();
  {
    const int col = tid & 63, part = (tid >> 6) & 3;
    const float glast = gcs[63];
    if (tid < 256) {
#pragma unroll 8
      for (int ii = 0; ii < 16; ++ii) { const int i = part * 16 + ii; qg[i * 64 + col] = f2bf(qs[i * 65 + col] * egs[i]); }
    } else {
#pragma unroll
      for (int c2 = 0; c2 < 2; ++c2) {
        const int c8 = part * 2 + c2;
        float e[8];
#pragma unroll
        for (int j = 0; j < 8; ++j) { const int i = c8 * 8 + j; e[j] = ks[i * 65 + col] * __expf(glast - gcs[i]); }
        uint4 o = {pk2(e[0], e[1]), pk2(e[2], e[3]), pk2(e[4], e[5]), pk2(e[6], e[7])};
        *(uint4*)(kdT + col * 64 + c8 * 8) = o;
      }
    }
    if (tid == 128) WSP(float, OFF_DEC)[job] = expf(glast);
  }
  __syncthreads();
  {
    const int col = tid & 63;
    const bool isw = (tid & 127) >= 64;
    float* xs = isw ? ks : vs;
    float* dbuf = qs;
    if (tid < 128) {
      float X[32];
#pragma unroll
      for (int i = 0; i < 32; ++i) {
        float rhs = xs[i * 65 + col] * betas[i];
        if (isw) rhs *= egs[i];
        float a0 = rhs, a1 = 0.f, a2 = 0.f, a3 = 0.f;
        const float* lrow = Ls + i * 64;
#pragma unroll
        for (int j4 = 0; j4 < (i >> 2); ++j4) {
          const float4 l4 = *(const float4*)(lrow + 4 * j4);
          a0 -= l4.x * X[4 * j4];
          a1 -= l4.y * X[4 * j4 + 1];
          a2 -= l4.z * X[4 * j4 + 2];
          a3 -= l4.w * X[4 * j4 + 3];
        }
        if ((i & 3) >= 1) a0 -= lrow[(i & ~3)] * X[(i & ~3)];
        if ((i & 3) >= 2) a1 -= lrow[(i & ~3) + 1] * X[(i & ~3) + 1];
        if ((i & 3) >= 3) a2 -= lrow[(i & ~3) + 2] * X[(i & ~3) + 2];
        X[i] = (a0 + a1) + (a2 + a3);
        xs[i * 65 + col] = X[i];
        if ((i & 3) == 3) asm volatile("" ::: "memory");
      }
      if (!isw) {
#pragma unroll
        for (int c8 = 0; c8 < 4; ++c8) {
          uint4 o = {pk2(X[c8 * 8], X[c8 * 8 + 1]), pk2(X[c8 * 8 + 2], X[c8 * 8 + 3]), pk2(X[c8 * 8 + 4], X[c8 * 8 + 5]), pk2(X[c8 * 8 + 6], X[c8 * 8 + 7])};
          *(uint4*)(uT + col * 64 + c8 * 8) = o;
        }
      } else {
        u16* wp = wnm + col;
#pragma unroll
        for (int i = 0; i < 32; ++i) { wp[i * 64] = f2bf(-X[i]); if ((i & 7) == 7) asm volatile("" ::: "memory"); }
      }
    }
    __syncthreads();
    {
      const int c = tid & 127, rg = tid >> 7;
      const float* xq = (c < 64 ? vs : ks) + (c & 63);
      float d[8];
#pragma unroll
      for (int e = 0; e < 8; ++e) d[e] = 0.f;
#pragma unroll
      for (int j4 = 0; j4 < 8; ++j4) {
        const float x0 = xq[(4 * j4) * 65], x1 = xq[(4 * j4 + 1) * 65], x2 = xq[(4 * j4 + 2) * 65], x3 = xq[(4 * j4 + 3) * 65];
#pragma unroll
        for (int e = 0; e < 8; ++e) {
          const float4 l4 = *(const float4*)(Ls + (32 + 8 * rg + e) * 64 + 4 * j4);
          d[e] += l4.x * x0 + l4.y * x1 + l4.z * x2 + l4.w * x3;
        }
      }
#pragma unroll
      for (int e = 0; e < 8; ++e) dbuf[(8 * rg + e) * 128 + c] = d[e];
    }
    __syncthreads();
    if (tid < 128) {
      float X[32];
#pragma unroll
      for (int ii = 0; ii < 32; ++ii) {
        const int i = 32 + ii;
        float rhs = xs[i * 65 + col] * betas[i];
        if (isw) rhs *= egs[i];
        float a0 = rhs - dbuf[ii * 128 + tid], a1 = 0.f, a2 = 0.f, a3 = 0.f;
        const float* lrow = Ls + i * 64 + 32;
#pragma unroll
        for (int j4 = 0; j4 < (ii >> 2); ++j4) {
          const float4 l4 = *(const float4*)(lrow + 4 * j4);
          a0 -= l4.x * X[4 * j4];
          a1 -= l4.y * X[4 * j4 + 1];
          a2 -= l4.z * X[4 * j4 + 2];
          a3 -= l4.w * X[4 * j4 + 3];
        }
        if ((ii & 3) >= 1) a0 -= lrow[(ii & ~3)] * X[(ii & ~3)];
        if ((ii & 3) >= 2) a1 -= lrow[(ii & ~3) + 1] * X[(ii & ~3) + 1];
        if ((ii & 3) >= 3) a2 -= lrow[(ii & ~3) + 2] * X[(ii & ~3) + 2];
        X[ii] = (a0 + a1) + (a2 + a3);
        if ((ii & 3) == 3) asm volatile("" ::: "memory");
      }
      if (!isw) {
#pragma unroll
        for (int c8 = 0; c8 < 4; ++c8) {
          uint4 o = {pk2(X[c8 * 8], X[c8 * 8 + 1]), pk2(X[c8 * 8 + 2], X[c8 * 8 + 3]), pk2(X[c8 * 8 + 4], X[c8 * 8 + 5]), pk2(X[c8 * 8 + 6], X[c8 * 8 + 7])};
          *(uint4*)(uT + col * 64 + 32 + c8 * 8) = o;
        }
      } else {
        u16* wp = wnm + col + 32 * 64;
#pragma unroll
        for (int i = 0; i < 32; ++i) { wp[i * 64] = f2bf(-X[i]); if ((i & 7) == 7) asm volatile("" ::: "memory"); }
      }
    }
  }
}

DI void phase4(const P& p, unsigned char* smem) {
  int item = blockIdx.x;
  for (; item < NJOBS; item += gridDim.x) gdn_prep(p, smem, item);
  for (; item < NJOBS + NRT * 3; item += gridDim.x) up_q_tile(p, smem, item - NJOBS);
  for (; item < NJOBS + NRT * 7; item += gridDim.x) up_kv_tile(p, smem, item - NJOBS - NRT * 3);
  u16* vt = WSP(u16, OFF_VT);
  for (int idx = blockIdx.x * NTHR + threadIdx.x; idx < NB * 8 * 64 * 48; idx += gridDim.x * NTHR) {
    const int rowi = idx / 48, c = idx - rowi * 48;
    vt[(size_t)rowi * LP + L + c] = 0;
  }
}

DI void gdn_scan(const P& p, unsigned char* smem, int bh) {
  const int tid = threadIdx.x & 255, lane = tid & 63, w = tid >> 6, l32 = lane & 31, hh = lane >> 5;
  const int hd = bh & 7, b = bh >> 3;
  u16* ops = (u16*)smem;
  float* os = (float*)(smem + 5 * 64 * 68 * 2);
  const u16* gbase = WSP(u16, OFF_Y) + (size_t)bh * NCH * 20480;
  const float* decs = WSP(float, OFF_DEC) + bh * NCH;
  const u16* projZ = WSP(u16, OFF_PROJZ);
  u16* ogdn = WSP(u16, OFF_OGDN);
  f32x16 S[2];
#pragma unroll
  for (int r = 0; r < 16; ++r) { S[0][r] = 0.f; S[1][r] = 0.f; }
  uint4 st[10];
  auto gload = [&](int n) __attribute__((always_inline)) {
    const u16* src = gbase + (size_t)n * 20480;
#pragma unroll
    for (int i = 0; i < 10; ++i) st[i] = *(const uint4*)(src + (size_t)(tid + 256 * i) * 8);
  };
  auto sstore = [&]() __attribute__((always_inline)) {
#pragma unroll
    for (int i = 0; i < 10; ++i) {
      const int c = tid + 256 * i;
      u16* d = ops + (c >> 3) * 68 + (c & 7) * 8;
      *(uint2*)d = make_uint2(st[i].x, st[i].y);
      *(uint2*)(d + 4) = make_uint2(st[i].z, st[i].w);
    }
  };
  __syncthreads();
  gload(0);
  sstore();
  __syncthreads();
  for (int n = 0; n < NCH; ++n) {
    const float dS = decs[n];
    uint4 z0 = make_uint4(0u, 0u, 0u, 0u), z1 = z0;
    {
      const int i_ = tid >> 2, q4_ = tid & 3, t_ = 64 * n - 48 + i_;
      if (t_ >= 0) { const u16* zp_ = projZ + (size_t)(b * L + t_) * 512 + hd * 64 + q4_ * 16; z0 = *(const uint4*)zp_; z1 = *(const uint4*)(zp_ + 8); }
    }
    if (n + 1 < NCH) gload(n + 1);
    if (w < 2) {
      const int nh = w;
      const u16* uT = ops;
      const u16* wnm = ops + 64 * 68;
      const u16* qg = ops + 2 * 64 * 68;
      const u16* intra = ops + 3 * 64 * 68;
      const u16* kdT = ops + 4 * 64 * 68;
      bf16x8 Sb[4];
#pragma unroll
      for (int ks = 0; ks < 4; ++ks) Sb[ks] = pack8(S[ks >> 1], ks & 1);
      f32x16 vn[2];
#pragma unroll
      for (int mt = 0; mt < 2; ++mt)
#pragma unroll
        for (int g = 0; g < 4; ++g) {
          const uint2 uu = *(const uint2*)(uT + (32 * nh + l32) * 68 + 32 * mt + 8 * g + 4 * hh);
          vn[mt][4 * g + 0] = __uint_as_float(uu.x << 16);
          vn[mt][4 * g + 1] = __uint_as_float(uu.x & 0xffff0000u);
          vn[mt][4 * g + 2] = __uint_as_float(uu.y << 16);
          vn[mt][4 * g + 3] = __uint_as_float(uu.y & 0xffff0000u);
        }
#pragma unroll
      for (int mt = 0; mt < 2; ++mt)
#pragma unroll
        for (int ks = 0; ks < 4; ++ks) vn[mt] = MFMA(perm_read(wnm, 32 * mt + l32, 68, ks, hh), Sb[ks], vn[mt]);
      bf16x8 vb[4];
#pragma unroll
      for (int ks = 0; ks < 4; ++ks) vb[ks] = pack8(vn[ks >> 1], ks & 1);
      f32x16 oa[2];
#pragma unroll
      for (int r = 0; r < 16; ++r) { oa[0][r] = 0.f; oa[1][r] = 0.f; }
#pragma unroll
      for (int mt = 0; mt < 2; ++mt)
#pragma unroll
        for (int ks = 0; ks < 4; ++ks) {
          oa[mt] = MFMA(perm_read(qg, 32 * mt + l32, 68, ks, hh), Sb[ks], oa[mt]);
          oa[mt] = MFMA(perm_read(intra, 32 * mt + l32, 68, ks, hh), vb[ks], oa[mt]);
        }
#pragma unroll
      for (int mt = 0; mt < 2; ++mt) {
#pragma unroll
        for (int r = 0; r < 16; ++r) S[mt][r] *= dS;
#pragma unroll
        for (int ks = 0; ks < 4; ++ks) S[mt] = MFMA(perm_read(kdT, 32 * mt + l32, 68, ks, hh), vb[ks], S[mt]);
      }
#pragma unroll
      for (int mt = 0; mt < 2; ++mt)
#pragma unroll
        for (int r = 0; r < 16; ++r) os[(32 * mt + 8 * (r >> 2) + 4 * hh + (r & 3)) * 65 + 32 * nh + l32] = oa[mt][r];
    }
    __syncthreads();
    {
      const int i = tid >> 2, q4 = tid & 3;
      const int t = 64 * n - 48 + i;
      float ov[16];
      float ss = 0.f;
#pragma unroll
      for (int j = 0; j < 16; ++j) { ov[j] = os[i * 65 + q4 * 16 + j]; ss += ov[j] * ov[j]; }
      ss += __shfl_xor(ss, 1);
      ss += __shfl_xor(ss, 2);
      const float rstd = rsqrtf(ss * (1.f / 64.f) + EPS);
      if (t >= 0) {
        const size_t grow = (size_t)(b * L + t);
        const float* gw = p.gdnn + q4 * 16;
#define GZ(zw, j) pk2(ov[2 * (j)] * rstd * gw[2 * (j)] * fsilu(__uint_as_float((zw) << 16)), ov[2 * (j) + 1] * rstd * gw[2 * (j) + 1] * fsilu(__uint_as_float((zw) & 0xffff0000u)))
        const uint4 o0 = make_uint4(GZ(z0.x, 0), GZ(z0.y, 1), GZ(z0.z, 2), GZ(z0.w, 3));
        const uint4 o1 = make_uint4(GZ(z1.x, 4), GZ(z1.y, 5), GZ(z1.z, 6), GZ(z1.w, 7));
#undef GZ
        u16* op = ogdn + grow * 512 + hd * 64 + q4 * 16;
        *(uint4*)op = o0;
        *(uint4*)(op + 8) = o1;
      }
    }
    if (n + 1 < NCH) sstore();
    __syncthreads();
  }
}

constexpr int KLD = 104, VLD = 68;
constexpr int ATT_STAGE = 64 * KLD + 64 * VLD;
DI void attn_item(const P& p, unsigned char* smem, int qi, int bh) {
  const int tid = threadIdx.x & 255, lane = tid & 63, w = tid >> 6, l32 = lane & 31, hh = lane >> 5;
  const int b = bh >> 3, hd = bh & 7;
  const int q0 = qi == 0 ? 0 : 16 + 128 * (qi - 1);
  const int nrows = qi == 0 ? 16 : 128;
  const int ntile = (q0 + nrows - 1) / 64 + 1;
  u16* lds = (u16*)smem;
  const u16* qb = WSP(u16, OFF_Q);
  const u16* kn = WSP(u16, OFF_KN);
  const u16* kr = WSP(u16, OFF_KR);
  const u16* vt = WSP(u16, OFF_VT) + (size_t)(b * 8 + hd) * 64 * LP;
  const int qlocal = 32 * w + l32;
  const int qpos = q0 + qlocal;
  const int qposc = qpos < L ? qpos : L - 1;
  const int qmin_w = q0 + 32 * w, qmax_w = q0 + 32 * w + 31;
  bf16x8 Qf[6];
  {
    const u16* qp = qb + (size_t)(b * L + qposc) * 768 + hd * 96 + 8 * hh;
#pragma unroll
    for (int ks = 0; ks < 6; ++ks) Qf[ks] = *(const bf16x8*)(qp + 16 * ks);
  }
  uint4 rk0, rk1, rk2, rv0, rv1;
#define KLD_(i, dst)                                                                                  \
  {                                                                                                   \
    const int c = tid + 256 * (i), r = c / 12, kc = c - r * 12;                                       \
    const size_t grow = (size_t)(b * L + kv0_ + r);                                                   \
    const u16* src_ = kc < 8 ? kn + grow * 512 + hd * 64 + kc * 8 : kr + grow * 32 + (kc - 8) * 8;    \
    dst = *(const uint4*)src_;                                                                        \
  }
#define VLD_(i, dst)                                                                                  \
  {                                                                                                   \
    const int c = tid + 256 * (i), r = c >> 3, kc = c & 7;                                            \
    dst = *(const uint4*)(vt + (size_t)r * LP + kv0_ + kc * 8);                                       \
  }
#define A_LOAD(kt_) { const int kv0_ = (kt_) * 64; KLD_(0, rk0) KLD_(1, rk1) KLD_(2, rk2) VLD_(0, rv0) VLD_(1, rv1) }
#define KST_(i, v) { const int c = tid + 256 * (i), r = c / 12, kc = c - r * 12; *(uint4*)(Ks_ + r * KLD + kc * 8) = (v); }
#define VST_(i, v) { const int c = tid + 256 * (i), r = c >> 3, kc = c & 7; u16* d_ = Vs_ + r * VLD + kc * 8; *(uint2*)d_ = make_uint2((v).x, (v).y); *(uint2*)(d_ + 4) = make_uint2((v).z, (v).w); }
#define A_STORE(st_) { u16* Ks_ = lds + (st_) * ATT_STAGE; u16* Vs_ = Ks_ + 64 * KLD; KST_(0, rk0) KST_(1, rk1) KST_(2, rk2) VST_(0, rv0) VST_(1, rv1) }
  f32x16 ot[2];
#pragma unroll
  for (int r = 0; r < 16; ++r) { ot[0][r] = 0.f; ot[1][r] = 0.f; }
  float m = -INFINITY, lsum = 0.f;
  __syncthreads();
  A_LOAD(0);
  A_STORE(0);
  __syncthreads();
  for (int kt = 0; kt < ntile; ++kt) {
    if (kt + 1 < ntile) A_LOAD(kt + 1);
    const int kv0 = kt * 64;
    if (kv0 <= qmax_w) {
      const u16* Ks = lds + (kt & 1) * ATT_STAGE;
      const u16* Vs = Ks + 64 * KLD;
      f32x16 s[2];
#pragma unroll
      for (int r = 0; r < 16; ++r) { s[0][r] = 0.f; s[1][r] = 0.f; }
      bf16x8 kf[6][2];
#pragma unroll
      for (int ks = 0; ks < 6; ++ks)
#pragma unroll
        for (int mt = 0; mt < 2; ++mt) kf[ks][mt] = *(const bf16x8*)(Ks + (32 * mt + l32) * KLD + 16 * ks + 8 * hh);
      __builtin_amdgcn_sched_barrier(0);
#pragma unroll
      for (int ks = 0; ks < 6; ++ks)
#pragma unroll
        for (int mt = 0; mt < 2; ++mt) s[mt] = MFMA(kf[ks][mt], Qf[ks], s[mt]);
      bf16x8 vf[4][2];
#pragma unroll
      for (int ks = 0; ks < 4; ++ks)
#pragma unroll
        for (int mt = 0; mt < 2; ++mt) vf[ks][mt] = perm_read(Vs, 32 * mt + l32, VLD, ks, hh);
      __builtin_amdgcn_sched_barrier(0);
      if (kv0 + 63 > qmin_w) {
#pragma unroll
        for (int mt = 0; mt < 2; ++mt)
#pragma unroll
          for (int r = 0; r < 16; ++r) {
            const int key = kv0 + 32 * mt + 8 * (r >> 2) + 4 * hh + (r & 3);
            if (key > qpos) s[mt][r] = -INFINITY;
          }
      }
      float mx = s[0][0];
#pragma unroll
      for (int r = 1; r < 16; ++r) mx = fmaxf(mx, s[0][r]);
#pragma unroll
      for (int r = 0; r < 16; ++r) mx = fmaxf(mx, s[1][r]);
      mx = fmaxf(mx, __shfl_xor(mx, 32));
      const float mnew = fmaxf(m, mx);
      const float alpha = __builtin_amdgcn_exp2f(m - mnew);
      m = mnew;
      float ps = 0.f;
#pragma unroll
      for (int mt = 0; mt < 2; ++mt)
#pragma unroll
        for (int r = 0; r < 16; ++r) { const float e = __builtin_amdgcn_exp2f(s[mt][r] - mnew); s[mt][r] = e; ps += e; }
      lsum = lsum * alpha + ps;
      if (__builtin_amdgcn_ballot_w64(alpha != 1.f) != 0ull) {
#pragma unroll
        for (int r = 0; r < 16; ++r) { ot[0][r] *= alpha; ot[1][r] *= alpha; }
      }
      bf16x8 pb[4];
#pragma unroll
      for (int ks = 0; ks < 4; ++ks) pb[ks] = pack8(s[ks >> 1], ks & 1);
#pragma unroll
      for (int ks = 0; ks < 4; ++ks)
#pragma unroll
        for (int mt = 0; mt < 2; ++mt) ot[mt] = MFMA(vf[ks][mt], pb[ks], ot[mt]);
    }
    if (kt + 1 < ntile) A_STORE((kt + 1) & 1);
    __syncthreads();
  }
#undef A_LOAD
#undef A_STORE
  lsum += __shfl_xor(lsum, 32);
  const float inv = 1.f / lsum;
  if (qlocal < nrows && qpos < L) {
    u16* op = WSP(u16, OFF_OMLA) + (size_t)(b * L + qpos) * 512 + hd * 64;
#pragma unroll
    for (int mt = 0; mt < 2; ++mt)
#pragma unroll
      for (int g = 0; g < 4; ++g) {
        uint2 o = {pk2(ot[mt][4 * g] * inv, ot[mt][4 * g + 1] * inv), pk2(ot[mt][4 * g + 2] * inv, ot[mt][4 * g + 3] * inv)};
        *(uint2*)(op + 32 * mt + 8 * g + 4 * hh) = o;
      }
  }
}

DI void hb1_item(const P& p, int rt) {
  const int tid = threadIdx.x & 255, lane = tid & 63, w = tid >> 6;
  u16* hb1 = WSP(u16, OFF_HB1);
  float4 g[4];
#pragma unroll
  for (int i = 0; i < 4; ++i) g[i] = *(const float4*)(p.nmix + lane * 4 + 256 * i);
  for (int rr = 0; rr < 32; rr += 4) {
    const int r0 = rt * 128 + w * 32 + rr;
    if (r0 >= T) break;
    float4 v[4][4];
#pragma unroll
    for (int q = 0; q < 4; ++q) {
      const float* src = hrow(p, r0 + q);
#pragma unroll
      for (int i = 0; i < 4; ++i) v[q][i] = *(const float4*)(src + lane * 4 + 256 * i);
    }
#pragma unroll
    for (int q = 0; q < 4; ++q)
#pragma unroll
      for (int i = 0; i < 4; ++i) {
        uint2 o = {pk2(v[q][i].x * g[i].x, v[q][i].y * g[i].y), pk2(v[q][i].z * g[i].z, v[q][i].w * g[i].w)};
        *(uint2*)(hb1 + (size_t)(r0 + q) * 1024 + lane * 4 + 256 * i) = o;
      }
  }
}

constexpr int NATTP = 33 * 16, NHB1P = 65;
DI void phase5(const P& p, unsigned char* smem) {
  const int half = (__builtin_amdgcn_readfirstlane(threadIdx.x >> 8) & 1);
  unsigned char* hsm = smem + half * HALF_SMEM;
  if (blockIdx.x < 16) gdn_scan(p, hsm, 2 * blockIdx.x + half);
  int* sitem = (int*)(smem + 2 * HALF_SMEM);
  int* cnt = WSP(int, OFF_CNT);
  for (;;) {
    __syncthreads();
    if (threadIdx.x == 0) *sitem = atomicAdd(cnt, 1);
    __syncthreads();
    const int ip = *sitem;
    if (ip >= NATTP + NHB1P) break;
    if (ip < NATTP) attn_item(p, hsm, 32 - (ip >> 4), 2 * (ip & 15) + half);
    else hb1_item(p, 2 * (ip - NATTP) + half);
  }
}

DI void phase_merge(const P& p, unsigned char* smem) {
  u16* lds = (u16*)smem;
  float* rs = (float*)(smem + RS_OFF);
  u16* merged = WSP(u16, OFF_MERGED);
  for (int tile = blockIdx.x; tile < NRT * 4; tile += gridDim.x) {
    int rt, ct;
    tile_map(tile, 4, rt, ct);
    const int row0 = rt * 256, col0 = ct * 256;
    __syncthreads();
    f32x16 acc[4][2];
    u16* slotB = WSP(u16, OFF_HB);
#define CB4 if ((r & 3) == 3) { asm volatile("" ::: "memory"); __builtin_amdgcn_sched_barrier(0); }
#define CB16 if (nt == 1 && r == 15) { asm volatile("" ::: "memory"); __builtin_amdgcn_sched_barrier(0); }
#define EIDX(mt, nt, r) ((unsigned)(row0 + LROW(mt, r)) * 1024u + (unsigned)(col0 + wn * 64 + (nt) * 32 + l32) + ob)
#define OPQ unsigned ob = 0; asm volatile("" : "+v"(ob));
#define ELOOP _Pragma("unroll") for (int mt = 0; mt < 4; ++mt) _Pragma("unroll") for (int nt = 0; nt < 2; ++nt) _Pragma("unroll") for (int r = 0; r < 16; ++r)
    zero_acc(acc);
    gemm_accum<0>(acc, lds, p, WSP(u16, OFF_HB1), 1024, nullptr, WSP(u16, OFF_WGG), 1024, 1024, row0, col0, RsReq{rs, WSP(float, OFF_SSQ1), 16, 1.f / 1024.f});
    { TILE_SETUP OPQ
      ELOOP {
        merged[EIDX(mt, nt, r)] = f2bf(fsigmoid(acc[mt][nt][r] * rs[LROW(mt, r) + ob]));
        CB4
      }
    }
    zero_acc(acc);
    gemm_accum<0>(acc, lds, p, WSP(u16, OFF_HB1), 1024, nullptr, WSP(u16, OFF_WGM), 1024, 1024, row0, col0);
    { TILE_SETUP OPQ
      ELOOP {
        slotB[EIDX(mt, nt, r)] = f2bf(fmaxf(fsigmoid(acc[mt][nt][r] * rs[LROW(mt, r) + ob]), 1e-6f));
        CB4
      }
    }
  }
  for (int tile = blockIdx.x; tile < NRT * 4; tile += gridDim.x) {
    int rt, ct;
    tile_map(tile, 4, rt, ct);
    const int row0 = rt * 256, col0 = ct * 256;
    f32x16 acc[4][2];
    u16* slotB = WSP(u16, OFF_HB);
    zero_acc(acc);
    gemm_accum<0>(acc, lds, p, WSP(u16, OFF_OGDN), 512, nullptr, WSP(u16, OFF_WGO), 512, 512, row0, col0);
    { TILE_SETUP OPQ
      ELOOP {
        const unsigned e = EIDX(mt, nt, r);
        merged[e] = f2bf(acc[mt][nt][r] * bf2f(merged[e]));
        CB16
      }
    }
    zero_acc(acc);
    gemm_accum<0>(acc, lds, p, WSP(u16, OFF_OMLA), 512, nullptr, WSP(u16, OFF_WMO), 512, 512, row0, col0);
    { TILE_SETUP OPQ
      ELOOP {
        const unsigned e = EIDX(mt, nt, r);
        merged[e] = f2bf(bf2f(merged[e]) + acc[mt][nt][r] * bf2f(slotB[e]));
        CB16
      }
    }
#undef CB4
#undef CB16
#undef EIDX
#undef OPQ
#undef ELOOP
  }
  const int half = (__builtin_amdgcn_readfirstlane(otid() >> 8) & 1);
  float* ts = (float*)(smem + half * HALF_SMEM);
  for (int ip = obid(); ip < 352 * 3; ip += gridDim.x) {
    int it = 2 * ip + half;
    if (tr_try(it, TrDesc{p.wg2, 2816, 1024, 2816, 16, 44, WSP(u16, OFF_W1T), 1}, ts)) continue;
    if (tr_try(it, TrDesc{p.wu2, 2816, 1024, 2816, 16, 44, WSP(u16, OFF_W1T), 2}, ts)) continue;
    if (tr_try(it, TrDesc{p.wd2, 1024, 2816, 1024, 44, 16, WSP(u16, OFF_W2T), 0}, ts)) continue;
  }
}

DI void phase_final(const P& p) {
  const int tid = otid(), lane = tid & 63, w = tid >> 6;
  const int bid = obid();
  const float* ssq = WSP(float, OFF_SSQ3);
  float4 g[4];
#pragma unroll
  for (int i = 0; i < 4; ++i) g[i] = *(const float4*)(p.nf + lane * 4 + 256 * i);
  for (int orow0 = (bid * 8 + w) * 4; orow0 < NB * 4096; orow0 += gridDim.x * 8 * 4) {
    float4 v[4][4];
    float4 q0[4], q1[4], q2[4], q3[4];
#pragma unroll
    for (int q = 0; q < 4; ++q) {
      const int orow = orow0 + q, b = orow >> 12, s_ = orow & 4095, r = b * L + 16 + s_;
      const float* sp = ssq + (size_t)r * 16;
      q0[q] = *(const float4*)sp; q1[q] = *(const float4*)(sp + 4); q2[q] = *(const float4*)(sp + 8); q3[q] = *(const float4*)(sp + 12);
      const float* op = p.out + (size_t)orow * 1024;
#pragma unroll
      for (int i = 0; i < 4; ++i) v[q][i] = *(const float4*)(op + lane * 4 + 256 * i);
    }
#pragma unroll
    for (int q = 0; q < 4; ++q) {
      const float a = ((q0[q].x + q0[q].y) + (q0[q].z + q0[q].w)) + ((q1[q].x + q1[q].y) + (q1[q].z + q1[q].w)) +
                      ((q2[q].x + q2[q].y) + (q2[q].z + q2[q].w)) + ((q3[q].x + q3[q].y) + (q3[q].z + q3[q].w));
      const float rstd = rsqrtf(a * (1.f / 1024.f) + EPS);
      float* op = p.out + (size_t)(orow0 + q) * 1024;
#pragma unroll
      for (int i = 0; i < 4; ++i) {
        float4 o = v[q][i];
        o.x *= rstd * g[i].x; o.y *= rstd * g[i].y; o.z *= rstd * g[i].z; o.w *= rstd * g[i].w;
        *(float4*)(op + lane * 4 + 256 * i) = o;
      }
    }
  }
}

#define XB_TMO      128
#define XB_XCNT(j)  (256  + 64 * (j))
#define XB_XSUB(j)  (1280 + 64 * (j))
#define XB_XGEN(j)  (2304 + 64 * (j))
#define XB_TOP      3328
#define XB_TOPGEN   3392
#define XB_SPIN_CAP (1u << 22)
#define LAS __attribute__((address_space(3)))
DI unsigned xb_ld(unsigned* p) { return __hip_atomic_load(p, __ATOMIC_RELAXED, __HIP_MEMORY_SCOPE_AGENT); }
DI unsigned xb_add(unsigned* p, unsigned v) { return __hip_atomic_fetch_add(p, v, __ATOMIC_RELAXED, __HIP_MEMORY_SCOPE_AGENT); }
DI unsigned xb_xcc_id() { return (unsigned)__builtin_amdgcn_s_getreg((3 << 11) | 20) & 0xFu; }
#define XB_SPIN(cond, bar) do { unsigned _sp = 0; while (cond) { __builtin_amdgcn_s_sleep(1); \
    if ((++_sp & 255u) == 0u) { if (xb_ld(&(bar)[XB_TMO])) break; if (_sp > XB_SPIN_CAP) { atomicAdd(&(bar)[XB_TMO], 1u); break; } } } } while (0)
struct XcdBarrier { unsigned* bar; unsigned x; volatile LAS unsigned* st; };
DI XcdBarrier xcd_barrier_post(unsigned* bar, volatile LAS unsigned* st) {
  XcdBarrier b; b.bar = bar; b.x = xb_xcc_id(); b.st = st;
  if (threadIdx.x == 0) (void)xb_add(&bar[XB_XCNT(b.x)], 1u);
  return b;
}
DI void xcd_barrier_complete(unsigned* bar, unsigned x, unsigned& nloc, unsigned& nx) {
  const unsigned G = gridDim.x * gridDim.y * gridDim.z;
  unsigned sum, cnt, mine, sp = 0u;
  for (;;) {
    sum = 0u; cnt = 0u; mine = 0u;
#pragma unroll
    for (unsigned j = 0; j < 16; ++j) { const unsigned c = xb_ld(&bar[XB_XCNT(j)]); sum += c; cnt += (c > 0u) ? 1u : 0u; mine = (j == x) ? c : mine; }
    if (sum == G) break;
    __builtin_amdgcn_s_sleep(1);
    if ((++sp & 255u) == 0u) { if (xb_ld(&bar[XB_TMO])) break; if (sp > XB_SPIN_CAP) { atomicAdd(&bar[XB_TMO], 1u); break; } }
  }
  nloc = mine > 0u ? mine : 1u; nx = cnt > 0u ? cnt : 1u;
}
DI void xcd_barrier(const XcdBarrier& b) {
  asm volatile("s_waitcnt vmcnt(0)" ::: "memory");
  __syncthreads();
  if (threadIdx.x == 0) {
    unsigned* bar = b.bar;
    __builtin_amdgcn_s_waitcnt(0);
    unsigned nloc = b.st[0], nx = b.st[1];
    if (nloc == 0u) { xcd_barrier_complete(bar, b.x, nloc, nx); b.st[0] = nloc; b.st[1] = nx; }
    const unsigned old = xb_add(&bar[XB_XSUB(b.x)], 1u);
    const unsigned gen = old / nloc;
    if (old + 1u == (gen + 1u) * nloc) {
      __builtin_amdgcn_fence(__ATOMIC_RELEASE, "agent");
      asm volatile("s_waitcnt vmcnt(0)" ::: "memory");
      const unsigned og = xb_add(&bar[XB_TOP], 1u);
      const unsigned tg = og / nx;
      if (og + 1u == (tg + 1u) * nx) xb_add(&bar[XB_TOPGEN], 1u);
      else XB_SPIN(xb_ld(&bar[XB_TOPGEN]) == tg, bar);
      __builtin_amdgcn_fence(__ATOMIC_ACQUIRE, "agent");
      xb_add(&bar[XB_XGEN(b.x)], 1u);
      asm volatile("s_waitcnt vmcnt(0)" ::: "memory");
    } else {
      XB_SPIN(xb_ld(&bar[XB_XGEN(b.x)]) == gen, bar);
      __builtin_amdgcn_fence(__ATOMIC_ACQUIRE, "agent");
      asm volatile("s_waitcnt vmcnt(0)" ::: "memory");
    }
  }
  __syncthreads();
}

template <int PH>
DI void run_phase(const P& p, unsigned char* smem) {
  if (PH == 0) phase0(p, smem);
  else if (PH == 1) phase_gateup(p, smem, WSP(u16, OFF_W1T), WSP(float, OFF_SSQ0));
  else if (PH == 2) phase_resid<0>(p, smem);
  else if (PH == 3) phase_inproj(p, smem);
  else if (PH == 4) phase4(p, smem);
  else if (PH == 5) phase5(p, smem);
  else if (PH == 6) phase_merge(p, smem);
  else if (PH == 7) phase_resid<1>(p, smem);
  else if (PH == 8) phase_gateup(p, smem, WSP(u16, OFF_W1T), WSP(float, OFF_SSQ2));
  else if (PH == 9) phase_resid<2>(p, smem);
  else phase_final(p);
}

#if MULTI
template <int PH>
__global__ void __launch_bounds__(NTHR, 1) k_phase(P p) {
  __shared__ __attribute__((aligned(16))) unsigned char smem[SMEM_BYTES];
  run_phase<PH>(p, smem);
}
#else
__global__ void __launch_bounds__(NTHR, 1) k_mega(P p) {
  __shared__ __attribute__((aligned(16))) unsigned char smem[SMEM_BYTES];
  cg::grid_group grid = cg::this_grid();
  __shared__ uint4 xb_words;
  if (threadIdx.x == 0) xb_words = make_uint4(0u, 0u, 0u, 0u);
  __syncthreads();
  const XcdBarrier xb = xcd_barrier_post(WSP(unsigned, OFF_BAR), (volatile LAS unsigned*)&xb_words);
  run_phase<0>(p, smem); xcd_barrier(xb);
  if (p.ws == nullptr) grid.sync();
  run_phase<1>(p, smem); xcd_barrier(xb);
  run_phase<2>(p, smem); xcd_barrier(xb);
  run_phase<3>(p, smem); xcd_barrier(xb);
  run_phase<4>(p, smem); xcd_barrier(xb);
  run_phase<5>(p, smem); xcd_barrier(xb);
  run_phase<6>(p, smem); xcd_barrier(xb);
  run_phase<7>(p, smem); xcd_barrier(xb);
  run_phase<8>(p, smem); xcd_barrier(xb);
  run_phase<9>(p, smem); xcd_barrier(xb);
  run_phase<10>(p, smem);
}
#endif

extern "C" void kernel_launch(void* const* d_in, const int* in_sizes, int n_in, void* d_out, int out_size, void* d_ws, size_t ws_size,
                              hipStream_t stream) {
  if (n_in != 24 || ws_size < WS_TOTAL) { fprintf(stderr, "kernel_launch: unexpected n_in %d or ws_size %zu (< %zu)\n", n_in, ws_size, (size_t)WS_TOTAL); return; }
  P p{};
  const float** pp = (const float**)&p;
  for (int i = 0; i < 24; ++i) pp[i] = (const float*)d_in[i];
  p.out = (float*)d_out;
  p.ws = (unsigned char*)d_ws;
#if MULTI
  const int G = 256;
#define LAUNCH(PH) hipLaunchKernelGGL(k_phase<PH>, dim3(G), dim3(NTHR), 0, stream, p)
  LAUNCH(0); LAUNCH(1); LAUNCH(2); LAUNCH(3); LAUNCH(4); LAUNCH(5); LAUNCH(6); LAUNCH(7); LAUNCH(8); LAUNCH(9); LAUNCH(10);
#else
  static int grid_blocks = 0;
  if (!grid_blocks) {
    int dev = 0, cus = 0, per_cu = 0;
    hipGetDevice(&dev);
    hipDeviceGetAttribute(&cus, hipDeviceAttributeMultiprocessorCount, dev);
    hipOccupancyMaxActiveBlocksPerMultiprocessor(&per_cu, k_mega, NTHR, 0);
    if (per_cu < 1) per_cu = 1;
    if (per_cu > 1) per_cu = 1;
    grid_blocks = cus * per_cu;
  }
  if (hipMemsetAsync((char*)d_ws + OFF_BAR, 0, BAR_BYTES + SKC_BYTES, stream) != hipSuccess) { fprintf(stderr, "memset of barrier words failed\n"); return; }
  void* args[] = {&p};
  hipError_t e = hipLaunchCooperativeKernel((void*)k_mega, dim3(grid_blocks), dim3(NTHR), args, 0, stream);
  if (e != hipSuccess) fprintf(stderr, "cooperative launch failed: %s (grid %d)\n", hipGetErrorString(e), grid_blocks);
#endif
}
```

```cpp
#include <hip/hip_runtime.h>
#include <hip/hip_cooperative_groups.h>
#include <stdint.h>
#include <stdio.h>
namespace cg = cooperative_groups;

#ifndef MULTI
#define MULTI 0
#endif

#define DI __device__ __forceinline__
typedef unsigned short u16;
typedef short bf16x8 __attribute__((ext_vector_type(8)));
typedef short s16x4 __attribute__((ext_vector_type(4)));
typedef float f32x16 __attribute__((ext_vector_type(16)));
typedef __bf16 bf2_t __attribute__((ext_vector_type(2)));
typedef float f2_t __attribute__((ext_vector_type(2)));

#define MFMA(a, b, c) __builtin_amdgcn_mfma_f32_32x32x16_bf16((a), (b), (c), 0, 0, 0)
#define MFMAF(a, b, c) __builtin_amdgcn_mfma_f32_32x32x2f32((a), (b), (c), 0, 0, 0)

constexpr int NB = 4, L = 4112, T = NB * L, MP = 16640, NRT = 65, LP = 4160;
constexpr int NTHR = 512, HALF_SMEM = 74240;
constexpr int NCH = 65, NJOBS = 32 * NCH;
constexpr int NATT = 33 * 32;
constexpr float EPS = 1e-6f;
constexpr float QSCALE = 0.10206207261596577f * 1.4426950408889634f;

constexpr size_t OFF_WGM = 0;
constexpr size_t OFF_WGG = OFF_WGM + (size_t)1024 * 1024 * 2;
constexpr size_t OFF_WUQ = OFF_WGG + (size_t)1024 * 1024 * 2;
constexpr size_t OFF_WUKV = OFF_WUQ + (size_t)768 * 256 * 2;
constexpr size_t OFF_WMO = OFF_WUKV + (size_t)1024 * 128 * 2;
constexpr size_t OFF_WGO = OFF_WMO + (size_t)1024 * 512 * 2;
constexpr size_t OFF_WOUT = OFF_WGO + (size_t)1024 * 512 * 2;
constexpr size_t OFF_WIN = OFF_WOUT + (size_t)1024 * 1024 * 2;
constexpr size_t OFF_SSQ0 = OFF_WIN + (size_t)2560 * 1024 * 2;
constexpr size_t SSQ_SZ = (size_t)MP * 16 * 4;
constexpr size_t OFF_SSQ1 = OFF_SSQ0 + SSQ_SZ;
constexpr size_t OFF_SSQ2 = OFF_SSQ1 + SSQ_SZ;
constexpr size_t OFF_SSQ3 = OFF_SSQ2 + SSQ_SZ;
constexpr size_t OFF_SSQQ = OFF_SSQ3 + SSQ_SZ;
constexpr size_t OFF_SSQKV = OFF_SSQQ + (size_t)MP * 4 * 4;
constexpr size_t OFF_SIDE = OFF_SSQKV + (size_t)MP * 2 * 4;
constexpr size_t OFF_ROPE = OFF_SIDE + (size_t)64 * 1024 * 4;
constexpr size_t OFF_BA = OFF_ROPE + (size_t)L * 16 * 2 * 4;
constexpr size_t OFF_DEC = OFF_BA + (size_t)MP * 16 * 4;
constexpr size_t OFF_CNT = OFF_DEC + (size_t)NJOBS * 4 + 192;
constexpr size_t OFF_BAR = OFF_CNT + 256;
constexpr size_t BAR_BYTES = 3456 * 4;
constexpr size_t OFF_SKC = OFF_BAR + BAR_BYTES;
constexpr size_t SKC_BYTES = 256;
constexpr size_t OFF_X = (OFF_SKC + SKC_BYTES + 255) & ~(size_t)255;
constexpr size_t X_SZ = (size_t)MP * 2816 * 2;
constexpr size_t OFF_PROJA = OFF_X;
constexpr size_t OFF_PROJZ = OFF_X + (size_t)MP * 2048 * 2;
constexpr size_t OFF_OMLA = OFF_X;
constexpr size_t OFF_OGDN = OFF_X + (size_t)MP * 512 * 2;
constexpr size_t OFF_HB1 = OFF_X + (size_t)MP * 1024 * 2;
constexpr size_t OFF_Y = OFF_X + X_SZ;
constexpr size_t Y_SZ = (size_t)NJOBS * 40960;
constexpr size_t OFF_W1T = OFF_Y;
constexpr size_t OFF_W2T = OFF_W1T + (size_t)5632 * 1024 * 2;
constexpr size_t OFF_HB = OFF_W2T + (size_t)1024 * 2816 * 2;
constexpr size_t OFF_Z = OFF_Y + Y_SZ;
constexpr size_t OFF_Q = OFF_Z;
constexpr size_t OFF_KN = OFF_Q + (size_t)MP * 768 * 2;
constexpr size_t OFF_VT = OFF_KN + (size_t)MP * 512 * 2;
constexpr size_t OFF_KR = OFF_VT + (size_t)NB * 8 * 64 * LP * 2;
constexpr size_t OFF_MERGED = OFF_Z;
constexpr size_t OFF_SPLITK = OFF_Z + (size_t)36 * 1024 * 1024;
constexpr size_t WS_TOTAL = OFF_KR + (size_t)MP * 32 * 2;
static_assert(OFF_HB + (size_t)MP * 1024 * 2 <= OFF_Z, "Y region overflow");
static_assert(OFF_PROJZ + (size_t)MP * 512 * 2 <= OFF_Y, "X region overflow");

constexpr int SMEM_BYTES = 148544;
constexpr int LDT = 72;
constexpr int STAGE = 2 * 256 * LDT;
constexpr int RS_OFF = 2 * STAGE * 2;

struct P {
  const float *x, *meta, *n1, *wg1, *wu1, *wd1, *nmix, *win, *qn, *wuq, *kvn, *wukv, *wmo, *convw, *alog, *dtb, *gdnn, *wgo, *wout, *n2, *wg2, *wu2, *wd2, *nf;
  float* out;
  unsigned char* ws;
};

#define WSP(type, off) ((type*)(p.ws + (off)))

DI int otid() { int t = threadIdx.x; asm volatile("" : "+v"(t)); return t; }
DI int obid() { int b = blockIdx.x; asm volatile("" : "+s"(b)); return b; }
DI unsigned pk2(float a, float b) {
  f2_t v = {a, b};
  bf2_t r = __builtin_convertvector(v, bf2_t);
  return __builtin_bit_cast(unsigned, r);
}
DI u16 f2bf(float a) { return (u16)(pk2(a, 0.f) & 0xffffu); }
DI float bf2f(u16 v) { return __uint_as_float(((unsigned)v) << 16); }
DI float fsilu(float x) { return x * __builtin_amdgcn_rcpf(1.f + __expf(-x)); }
DI float fsigmoid(float x) { return __builtin_amdgcn_rcpf(1.f + __expf(-x)); }

DI const float* xrow(const P& p, int r) {
  int b = r / L, t = r - b * L;
  return t < 16 ? p.meta + t * 1024 : p.x + (size_t)(b * 4096 + t - 16) * 1024;
}
DI float* hrow(const P& p, int r) {
  int b = r / L, t = r - b * L;
  return t < 16 ? WSP(float, OFF_SIDE) + (b * 16 + t) * 1024 : p.out + (size_t)(b * 4096 + t - 16) * 1024;
}

DI bf16x8 pack8(const f32x16& x, int s) {
  unsigned a = pk2(x[8 * s + 0], x[8 * s + 1]), b = pk2(x[8 * s + 2], x[8 * s + 3]);
  unsigned c = pk2(x[8 * s + 4], x[8 * s + 5]), d = pk2(x[8 * s + 6], x[8 * s + 7]);
  uint4 u = {a, b, c, d};
  return __builtin_bit_cast(bf16x8, u);
}
DI bf16x8 perm_read(const u16* m, int row, int ld, int ks, int hh) {
  const u16* q = m + row * ld + 16 * ks + 4 * hh;
  uint2 lo = *(const uint2*)q;
  uint2 hi = *(const uint2*)(q + 8);
  uint4 u = {lo.x, lo.y, hi.x, hi.y};
  return __builtin_bit_cast(bf16x8, u);
}

DI float row_reduce32(float (&v)[32], int lane) {
#pragma unroll
  for (int k = 0; k < 16; ++k) { bool up = lane & 16; float send = up ? v[k] : v[k + 16]; float keep = up ? v[k + 16] : v[k]; v[k] = keep + __shfl_xor(send, 16); }
#pragma unroll
  for (int k = 0; k < 8; ++k) { bool up = lane & 8; float send = up ? v[k] : v[k + 8]; float keep = up ? v[k + 8] : v[k]; v[k] = keep + __shfl_xor(send, 8); }
#pragma unroll
  for (int k = 0; k < 4; ++k) { bool up = lane & 4; float send = up ? v[k] : v[k + 4]; float keep = up ? v[k + 4] : v[k]; v[k] = keep + __shfl_xor(send, 4); }
#pragma unroll
  for (int k = 0; k < 2; ++k) { bool up = lane & 2; float send = up ? v[k] : v[k + 2]; float keep = up ? v[k + 2] : v[k]; v[k] = keep + __shfl_xor(send, 2); }
  { bool up = lane & 1; float send = up ? v[0] : v[1]; float keep = up ? v[1] : v[0]; v[0] = keep + __shfl_xor(send, 1); }
  return v[0];
}

struct RsReq { float* rs; const float* ssq; int nslots; float invn; };
DI void rs_part(const RsReq& q, int row0) {
  const int tid = threadIdx.x;
  if (tid < 256) {
    const float* s = q.ssq + (size_t)(row0 + tid) * q.nslots;
    float a = 0.f;
    if (q.nslots == 16) {
      const float4 v0 = *(const float4*)s, v1 = *(const float4*)(s + 4), v2 = *(const float4*)(s + 8), v3 = *(const float4*)(s + 12);
      a = ((v0.x + v0.y) + (v0.z + v0.w)) + ((v1.x + v1.y) + (v1.z + v1.w)) + ((v2.x + v2.y) + (v2.z + v2.w)) + ((v3.x + v3.y) + (v3.z + v3.w));
    } else if (q.nslots == 4) {
      const float4 v0 = *(const float4*)s;
      a = (v0.x + v0.y) + (v0.z + v0.w);
    } else {
      const float2 v0 = *(const float2*)s;
      a = v0.x + v0.y;
    }
    q.rs[tid] = rsqrtf(a * q.invn + EPS);
  }
}

template <int AMODE>
DI void gemm_accum(f32x16 (&acc)[4][2], u16* lds, const P& p, const u16* A, int lda, const float* normw,
                   const u16* Bt, int ldb, int K, int row0, int col0, RsReq rq = RsReq{nullptr, nullptr, 0, 0.f}) {
  int tid = threadIdx.x;
  asm volatile("" : "+v"(tid));
  const int lane = tid & 63, w = tid >> 6, wm = w >> 2, wn = w & 3, l32 = lane & 31, hh = lane >> 5;
  int nk = K >> 6;
  asm volatile("" : "+s"(nk));
  int mvalid = (T - (row0 + wm * 128) + 31) >> 5;
  mvalid = mvalid < 0 ? 0 : (mvalid > 4 ? 4 : mvalid);
  uint4 ra0, ra1, ra2, ra3, rb0, rb1, rb2, rb3;
  float4 fa0, fa1, fa2, fa3, fa4, fa5, fa6, fa7;
  float4 nw;
  const int ldr = tid >> 3, ldkc = tid & 7;
  const char* Abase = (const char*)(A + (size_t)row0 * lda);
  const char* Bbase = (const char*)(Bt + (size_t)col0 * ldb);
  const unsigned aoff = (unsigned)(ldr * lda + ldkc * 8) * 2u, astep = (unsigned)(64 * lda) * 2u;
  const unsigned boff = (unsigned)(ldr * ldb + ldkc * 8) * 2u, bstep = (unsigned)(64 * ldb) * 2u;
  const int fr = tid >> 4, fkc = tid & 15;
#define LA_(i) (*(const uint4*)(Abase + (size_t)kt__ * 128 + (aoff + (unsigned)(i) * astep)))
#define LB_(i) (*(const uint4*)(Bbase + (size_t)kt__ * 128 + (boff + (unsigned)(i) * bstep)))
#define LF_(i) (*(const float4*)(hrow(p, (row0 + fr + 32 * (i)) < T ? (row0 + fr + 32 * (i)) : T - 1) + kt__ * 64 + fkc * 4))
#define G_LOAD(kt_)                                                                                       \
  {                                                                                                       \
    const int kt__ = (kt_);                                                                               \
    if (AMODE == 0) { ra0 = LA_(0); ra1 = LA_(1); ra2 = LA_(2); ra3 = LA_(3); }                           \
    else {                                                                                                \
      fa0 = LF_(0); fa1 = LF_(1); fa2 = LF_(2); fa3 = LF_(3); fa4 = LF_(4); fa5 = LF_(5); fa6 = LF_(6); fa7 = LF_(7); \
      nw = *(const float4*)(normw + kt__ * 64 + fkc * 4);                                                 \
    }                                                                                                     \
    rb0 = LB_(0); rb1 = LB_(1); rb2 = LB_(2); rb3 = LB_(3);                                               \
  }
#define SA_(i, v) *(uint4*)(As_ + (ldr + 64 * (i)) * LDT + ldkc * 8) = (v)
#define SB_(i, v) *(uint4*)(Bs_ + (ldr + 64 * (i)) * LDT + ldkc * 8) = (v)
#define SF_(i, f) { uint2 v_ = {pk2((f).x * nw.x, (f).y * nw.y), pk2((f).z * nw.z, (f).w * nw.w)}; *(uint2*)(As_ + (fr + 32 * (i)) * LDT + fkc * 4) = v_; }
#define S_STORE(st_)                                                                                      \
  {                                                                                                       \
    u16* As_ = lds + (st_) * STAGE;                                                                       \
    u16* Bs_ = As_ + 256 * LDT;                                                                           \
    if (AMODE == 0) { SA_(0, ra0); SA_(1, ra1); SA_(2, ra2); SA_(3, ra3); }                               \
    else { SF_(0, fa0) SF_(1, fa1) SF_(2, fa2) SF_(3, fa3) SF_(4, fa4) SF_(5, fa5) SF_(6, fa6) SF_(7, fa7) } \
    SB_(0, rb0); SB_(1, rb1); SB_(2, rb2); SB_(3, rb3);                                                   \
  }
  asm volatile("" ::: "memory");
  __builtin_amdgcn_sched_barrier(0);
  if (AMODE == 1 || row0 + 256 <= T) {
#define PIECE_STORE(i, st_)                                                                               \
  {                                                                                                       \
    u16* As_ = lds + (st_) * STAGE;                                                                       \
    u16* Bs_ = As_ + 256 * LDT;                                                                           \
    if (AMODE == 0) {                                                                                     \
      if ((i) == 0) SA_(0, ra0); if ((i) == 1) SA_(1, ra1); if ((i) == 2) SA_(2, ra2); if ((i) == 3) SA_(3, ra3); \
      if ((i) == 4) SB_(0, rb0); if ((i) == 5) SB_(1, rb1); if ((i) == 6) SB_(2, rb2); if ((i) == 7) SB_(3, rb3); \
    } else {                                                                                              \
      if ((i) == 0) { SF_(0, fa0) SB_(0, rb0); } if ((i) == 1) { SF_(1, fa1) SB_(1, rb1); }               \
      if ((i) == 2) { SF_(2, fa2) SB_(2, rb2); } if ((i) == 3) { SF_(3, fa3) SB_(3, rb3); }               \
      if ((i) == 4) SF_(4, fa4) if ((i) == 5) SF_(5, fa5) if ((i) == 6) SF_(6, fa6) if ((i) == 7) SF_(7, fa7) \
    }                                                                                                     \
  }
#define PIECE_LOAD(i, kt_)                                                                                \
  {                                                                                                       \
    const int kt__ = (kt_);                                                                               \
    if (AMODE == 0) {                                                                                     \
      if ((i) == 0) ra0 = LA_(0); if ((i) == 1) ra1 = LA_(1); if ((i) == 2) ra2 = LA_(2); if ((i) == 3) ra3 = LA_(3); \
      if ((i) == 4) rb0 = LB_(0); if ((i) == 5) rb1 = LB_(1); if ((i) == 6) rb2 = LB_(2); if ((i) == 7) rb3 = LB_(3); \
    } else {                                                                                              \
      if ((i) == 0) { fa0 = LF_(0); rb0 = LB_(0); } if ((i) == 1) { fa1 = LF_(1); rb1 = LB_(1); }         \
      if ((i) == 2) { fa2 = LF_(2); rb2 = LB_(2); } if ((i) == 3) { fa3 = LF_(3); rb3 = LB_(3); }         \
      if ((i) == 4) fa4 = LF_(4); if ((i) == 5) fa5 = LF_(5); if ((i) == 6) fa6 = LF_(6);                 \
      if ((i) == 7) { fa7 = LF_(7); nw = *(const float4*)(normw + kt__ * 64 + fkc * 4); }                 \
    }                                                                                                     \
  }
#define K_PIPE_PRO                                                                                       \
    G_LOAD(0);                                                                                            \
    if (rq.rs) rs_part(rq, row0);                                                                         \
    S_STORE(0);                                                                                           \
    G_LOAD(nk > 1 ? 1 : 0);                                                                               \
    __syncthreads();                                                                                      \
    int kt = 0;
#define K_BODY(HFN, DOLOAD)                                                                               \
    {                                                                                                     \
      const u16* As = lds + (kt & 1) * STAGE;                                                             \
      const u16* Bs = As + 256 * LDT;                                                                     \
      const u16* ap = As + (wm * 128 + l32) * LDT + hh * 8;                                               \
      const u16* bp = Bs + (wn * 64 + l32) * LDT + hh * 8;                                                \
      const int nst = (kt + 1) & 1;                                                                       \
      const int ktn = kt + 2 < nk ? kt + 2 : nk - 1;                                                      \
      bf16x8 af[2][2], bq[2][2];                                                                          \
      bq[0][0] = *(const bf16x8*)(bp);                                                                    \
      bq[0][1] = *(const bf16x8*)(bp + 32 * LDT);                                                         \
      af[0][0] = *(const bf16x8*)(ap);                                                                    \
      af[0][1] = *(const bf16x8*)(ap + 32 * LDT);                                                         \
      _Pragma("unroll") for (int sq = 0; sq < 4 * (HFN); ++sq) {                                          \
        const int st = (HFN) == 2 ? sq : 2 * sq;                                  \
        const int ks = st >> 1, hf = st & 1, cur = sq & 1, nxt = cur ^ 1;                                 \
        if (sq + 1 < 4 * (HFN)) {                                                                         \
          const int st2 = (HFN) == 2 ? sq + 1 : 2 * (sq + 1);                                             \
          const int ks2 = st2 >> 1, hf2 = st2 & 1;                                                        \
          af[nxt][0] = *(const bf16x8*)(ap + (hf2 * 2 + 0) * 32 * LDT + ks2 * 16);                        \
          af[nxt][1] = *(const bf16x8*)(ap + (hf2 * 2 + 1) * 32 * LDT + ks2 * 16);                        \
          if (hf2 == 0) {                                                                                 \
            bq[ks2 & 1][0] = *(const bf16x8*)(bp + ks2 * 16);                                             \
            bq[ks2 & 1][1] = *(const bf16x8*)(bp + 32 * LDT + ks2 * 16);                                  \
          }                                                                                               \
        }                                                                                                 \
        if ((HFN) == 2) { PIECE_STORE(sq, nst) if (DOLOAD) PIECE_LOAD(sq, ktn) }                          \
        else { PIECE_STORE(2 * sq, nst) PIECE_STORE(2 * sq + 1, nst) if (DOLOAD) { PIECE_LOAD(2 * sq, ktn) PIECE_LOAD(2 * sq + 1, ktn) } } \
        acc[hf * 2 + 0][0] = MFMA(af[cur][0], bq[ks & 1][0], acc[hf * 2 + 0][0]);                         \
        acc[hf * 2 + 0][1] = MFMA(af[cur][0], bq[ks & 1][1], acc[hf * 2 + 0][1]);                         \
        acc[hf * 2 + 1][0] = MFMA(af[cur][1], bq[ks & 1][0], acc[hf * 2 + 1][0]);                         \
        acc[hf * 2 + 1][1] = MFMA(af[cur][1], bq[ks & 1][1], acc[hf * 2 + 1][1]);                         \
        if ((sq & 1) == 1) __builtin_amdgcn_sched_barrier(0);               \
      }                                                                                                   \
      __syncthreads();                                                                                    \
    }
#define K_PIPE(HFN) K_PIPE_PRO for (; kt < nk - 2; ++kt) K_BODY(HFN, 1) for (; kt < nk; ++kt) K_BODY(HFN, 0)
    K_PIPE(2)
  } else {
    K_PIPE(1)
  }
#undef K_PIPE
#undef K_PIPE_PRO
#undef K_BODY
#undef PIECE_STORE
#undef PIECE_LOAD
  asm volatile("" ::: "memory");
  __builtin_amdgcn_sched_barrier(0);
#undef G_LOAD
#undef S_STORE
#undef LA_
#undef LB_
#undef LF_
#undef SA_
#undef SB_
#undef SF_
}

DI void zero_acc(f32x16 (&acc)[4][2]) {
#pragma unroll
  for (int i = 0; i < 4; ++i)
#pragma unroll
    for (int j = 0; j < 2; ++j)
#pragma unroll
      for (int r = 0; r < 16; ++r) acc[i][j][r] = 0.f;
}

#define EPI_SETUP
#define TILE_SETUP int tid_ = threadIdx.x; asm volatile("" : "+v"(tid_)); const int lane = tid_ & 63, w = tid_ >> 6, wm = w >> 2, wn = w & 3, l32 = lane & 31, hh = lane >> 5; (void)wn; (void)l32; (void)lane; (void)wm; (void)hh;
#define LROW(mt, r) (wm * 128 + (mt) * 32 + 8 * ((r) >> 2) + 4 * hh + ((r) & 3))

DI void tile_map(int it, int nct, int& rt, int& ct) {
  const int G = gridDim.x, k = it / G, b = it - k * G;
  const int per = G >> 3;
  const int o = ((G & 7) == 0 && (k + 1) * G <= 65 * nct) ? k * G + (b & 7) * per + (b >> 3) : it;
  const int nmain = 64 * nct;
  if (o >= nmain) { rt = 64; ct = o - nmain; return; }
  const int pw = 8 * 64;
  const int pnl = o / pw, w = (nct - pnl * 8) < 8 ? (nct - pnl * 8) : 8;
  const int oo = o - pnl * pw;
  rt = oo / w;
  ct = pnl * 8 + (oo - rt * w);
}

struct TrDesc { const float* src; int ldw; int K; int nvalid; int nk; int nn; u16* dst; int mode; };
DI int tr_drow(int n, int mode) {
  if (mode == 0) return n;
  return 128 * (n >> 6) + 64 * ((n & 63) >> 5) + 32 * (mode - 1) + (n & 31);
}
DI bool tr_try(int& it, const TrDesc& d, float* ts) {
  const int n = d.nk * d.nn;
  if (it >= n) { it -= n; return false; }
  const int kt = it % d.nk, nt = it / d.nk, k0 = kt * 64, n0 = nt * 64, tid = otid() & 255;
  __syncthreads();
  {
    float tv[16];
    const int nn = tid & 63, nc = n0 + nn;
#pragma unroll
    for (int i = 0; i < 16; ++i) { const int kk = i * 4 + (tid >> 6); tv[i] = nc < d.nvalid ? d.src[(size_t)(k0 + kk) * d.ldw + nc] : 0.f; }
#pragma unroll
    for (int i = 0; i < 16; ++i) { const int kk = i * 4 + (tid >> 6); ts[kk * 65 + nn] = tv[i]; }
  }
  __syncthreads();
#pragma unroll
  for (int i = 0; i < 2; ++i) {
    const int idx = tid + 256 * i, nn = idx >> 3, c = idx & 7;
    float e[8];
#pragma unroll
    for (int j = 0; j < 8; ++j) e[j] = ts[(c * 8 + j) * 65 + nn];
    uint4 o = {pk2(e[0], e[1]), pk2(e[2], e[3]), pk2(e[4], e[5]), pk2(e[6], e[7])};
    *(uint4*)(d.dst + (size_t)tr_drow(n0 + nn, d.mode) * d.K + k0 + c * 8) = o;
  }
  return true;
}

DI void phase0(const P& p, unsigned char* smem) {
  const int tid = otid(), lane = tid & 63, w = tid >> 6, half = (__builtin_amdgcn_readfirstlane(tid >> 8) & 1);
  const int bid = obid();
  float* ts = (float*)(smem + half * HALF_SMEM);
  const int NT0 = 704 * 3 + 640 + 256 * 2 + 48 + 32 + 128 * 2 + 256;
  for (int ip = bid; ip < NT0 / 2; ip += gridDim.x) {
    int it = 2 * ip + half;
    if (tr_try(it, TrDesc{p.wg1, 2816, 1024, 2816, 16, 44, WSP(u16, OFF_W1T), 1}, ts)) continue;
    if (tr_try(it, TrDesc{p.wu1, 2816, 1024, 2816, 16, 44, WSP(u16, OFF_W1T), 2}, ts)) continue;
    if (tr_try(it, TrDesc{p.wd1, 1024, 2816, 1024, 44, 16, WSP(u16, OFF_W2T), 0}, ts)) continue;
    if (tr_try(it, TrDesc{p.win, 4528, 1024, 2480, 16, 40, WSP(u16, OFF_WIN), 0}, ts)) continue;
    if (tr_try(it, TrDesc{p.win + 2480, 4528, 1024, 1024, 16, 16, WSP(u16, OFF_WGM), 0}, ts)) continue;
    if (tr_try(it, TrDesc{p.win + 3504, 4528, 1024, 1024, 16, 16, WSP(u16, OFF_WGG), 0}, ts)) continue;
    if (tr_try(it, TrDesc{p.wuq, 768, 256, 768, 4, 12, WSP(u16, OFF_WUQ), 0}, ts)) continue;
    if (tr_try(it, TrDesc{p.wukv, 1024, 128, 1024, 2, 16, WSP(u16, OFF_WUKV), 0}, ts)) continue;
    if (tr_try(it, TrDesc{p.wmo, 1024, 512, 1024, 8, 16, WSP(u16, OFF_WMO), 0}, ts)) continue;
    if (tr_try(it, TrDesc{p.wgo, 1024, 512, 1024, 8, 16, WSP(u16, OFF_WGO), 0}, ts)) continue;
    if (tr_try(it, TrDesc{p.wout, 1024, 1024, 1024, 16, 16, WSP(u16, OFF_WOUT), 0}, ts)) continue;
  }
  u16* hb = WSP(u16, OFF_HB);
  float* ssq0 = WSP(float, OFF_SSQ0);
  {
    float4 g4[4];
#pragma unroll
    for (int i = 0; i < 4; ++i) g4[i] = *(const float4*)(p.n1 + lane * 4 + 256 * i);
    for (int r0 = (bid * 8 + w) * 4; r0 < T; r0 += gridDim.x * 8 * 4) {
      float4 v[4][4];
#pragma unroll
      for (int q = 0; q < 4; ++q) {
        const float* src = xrow(p, r0 + q);
#pragma unroll
        for (int i = 0; i < 4; ++i) v[q][i] = *(const float4*)(src + lane * 4 + 256 * i);
      }
#pragma unroll
      for (int q = 0; q < 4; ++q) {
        float ss = 0.f;
#pragma unroll
        for (int i = 0; i < 4; ++i) {
          const float4 x4 = v[q][i];
          ss += x4.x * x4.x + x4.y * x4.y + x4.z * x4.z + x4.w * x4.w;
          uint2 o = {pk2(x4.x * g4[i].x, x4.y * g4[i].y), pk2(x4.z * g4[i].z, x4.w * g4[i].w)};
          *(uint2*)(hb + (size_t)(r0 + q) * 1024 + lane * 4 + 256 * i) = o;
        }
#pragma unroll
        for (int m = 32; m >= 1; m >>= 1) ss += __shfl_xor(ss, m);
        if (lane < 16) ssq0[(size_t)(r0 + q) * 16 + lane] = lane == 0 ? ss : 0.f;
      }
    }
  }
  float* cosT = WSP(float, OFF_ROPE);
  float* sinT = cosT + L * 16;
  for (int idx = bid * NTHR + tid; idx < L * 16; idx += gridDim.x * NTHR) {
    int pos = idx >> 4, i = idx & 15;
    double inv = 1.0;
    const double rr = 0.5623413251903491;
    for (int j = 0; j < i; ++j) inv *= rr;
    float ang = (float)pos * (float)inv;
    double q = (double)ang * 0.15915494309189535;
    q -= __builtin_rint(q);
    float fr = (float)q;
    ((float2*)cosT)[idx] = make_float2(__builtin_amdgcn_cosf(fr), __builtin_amdgcn_sinf(fr));
    (void)sinT;
  }
  if (bid == 0 && tid == 0) *WSP(int, OFF_CNT) = 0;
}

DI void phase_gateup(const P& p, unsigned char* smem, const u16* Wt, const float* ssq) {
  u16* lds = (u16*)smem;
  float* rs = (float*)(smem + RS_OFF);
  const u16* hb = WSP(u16, OFF_HB);
  u16* act = WSP(u16, OFF_X);
  for (int tile = blockIdx.x; tile < NRT * 22; tile += gridDim.x) {
    int rt, ct;
    tile_map(tile, 22, rt, ct);
    const int row0 = rt * 256, col0 = ct * 256;
    __syncthreads();
    f32x16 acc[4][2];
    zero_acc(acc);
    gemm_accum<0>(acc, lds, p, hb, 1024, nullptr, Wt, 1024, 1024, row0, col0, RsReq{rs, ssq, 16, 1.f / 1024.f});
    TILE_SETUP
#pragma unroll
    for (int mt = 0; mt < 4; ++mt)
#pragma unroll
      for (int r = 0; r < 16; ++r) {
        const int lr = LROW(mt, r), row = row0 + lr;
        const float s = rs[lr];
        const float g = acc[mt][0][r] * s, u = acc[mt][1][r] * s;
        act[(unsigned)(row * 2816 + ct * 128 + wn * 32 + l32)] = f2bf(fsilu(g) * u);
        if ((r & 3) == 3) asm volatile("" ::: "memory");
      }
  }
}

DI bool splitk_combine(f32x16 (&acc)[4][2], float* part, unsigned* cnt, int S, int sp, int ct, int* sflag) {
  int tid = threadIdx.x;
  asm volatile("" : "+v"(tid));
  float* base = part + (size_t)ct * S * 32768;
  float* mine = base + (size_t)sp * 32768 + tid;
#pragma unroll
  for (int mt = 0; mt < 2; ++mt)
#pragma unroll
    for (int nt = 0; nt < 2; ++nt)
#pragma unroll
      for (int r = 0; r < 16; ++r) mine[((mt * 2 + nt) * 16 + r) * 512] = acc[mt][nt][r];
  asm volatile("s_waitcnt vmcnt(0)" ::: "memory");
  __syncthreads();
  if (threadIdx.x == 0) {
    __threadfence();
    asm volatile("s_waitcnt vmcnt(0)" ::: "memory");
    const unsigned t = __hip_atomic_fetch_add(cnt + ct, 1u, __ATOMIC_RELAXED, __HIP_MEMORY_SCOPE_AGENT);
    const int last = t == (unsigned)(S - 1);
    if (last) { __threadfence(); asm volatile("s_waitcnt vmcnt(0)" ::: "memory"); }
    *sflag = last;
  }
  __syncthreads();
  if (!*sflag) return false;
  for (int s2 = 0; s2 < S; ++s2) {
    if (s2 == sp) continue;
    const float* o = base + (size_t)s2 * 32768 + tid;
#pragma unroll
    for (int mt = 0; mt < 2; ++mt)
#pragma unroll
      for (int nt = 0; nt < 2; ++nt)
#pragma unroll
        for (int r = 0; r < 16; ++r) acc[mt][nt][r] += o[((mt * 2 + nt) * 16 + r) * 512];
  }
  return true;
}

template <int MODE>
DI void phase_resid(const P& p, unsigned char* smem) {
  u16* lds = (u16*)smem;
  const u16* A = MODE == 1 ? WSP(u16, OFF_MERGED) : WSP(u16, OFF_X);
  const int K = MODE == 1 ? 1024 : 2816;
  const u16* Wt = MODE == 0 ? WSP(u16, OFF_W2T) : (MODE == 1 ? WSP(u16, OFF_WOUT) : WSP(u16, OFF_W2T));
  float* ssq = MODE == 0 ? WSP(float, OFF_SSQ1) : (MODE == 1 ? WSP(float, OFF_SSQ2) : WSP(float, OFF_SSQ3));
  const float scale = MODE == 1 ? 1.f : 0.5f;
  u16* hb = WSP(u16, OFF_HB);
  const int SPL = K / 256;
  unsigned* skc = WSP(unsigned, OFF_SKC) + MODE * 4;
  float* part = WSP(float, OFF_SPLITK);
  int* sflag = (int*)(smem + RS_OFF);
  for (int tile = blockIdx.x; tile < 256 + 4 * SPL; tile += gridDim.x) {
    int rt, ct, sp = -1;
    if (tile < 256) tile_map(tile, 4, rt, ct);
    else { rt = 64; ct = (tile - 256) & 3; sp = (tile - 256) >> 2; }
    const int row0 = rt * 256, col0 = ct * 256;
    f32x16 acc[4][2];
    zero_acc(acc);
    if (sp < 0) gemm_accum<0>(acc, lds, p, A, K, nullptr, Wt, K, K, row0, col0);
    else {
      gemm_accum<0>(acc, lds, p, A + sp * 256, K, nullptr, Wt + sp * 256, K, 256, row0, col0);
      if (!splitk_combine(acc, part, skc, SPL, sp, ct, sflag)) continue;
    }
    TILE_SETUP
#pragma unroll
    for (int mp = 0; mp < 2; ++mp) {
      float v[32];
#pragma unroll
      for (int m2 = 0; m2 < 2; ++m2) {
        const int mt = mp * 2 + m2;
        float sv[16][2];
#pragma unroll
        for (int r = 0; r < 16; ++r) {
          const int row = row0 + LROW(mt, r);
          const int rc = row < T ? row : T - 1;
          const float* src = MODE == 0 ? xrow(p, rc) : hrow(p, rc);
          sv[r][0] = src[col0 + wn * 64 + l32];
          sv[r][1] = src[col0 + wn * 64 + 32 + l32];
        }
        asm volatile("" ::: "memory");
#pragma unroll
        for (int r = 0; r < 16; ++r) {
          const int row = row0 + LROW(mt, r);
          const bool ok = row < T;
          const int rc = ok ? row : T - 1;
          float* dst = hrow(p, rc);
          float sq = 0.f;
#pragma unroll
          for (int nt = 0; nt < 2; ++nt) {
            const int col = col0 + wn * 64 + nt * 32 + l32;
            const float hv = sv[r][nt] + scale * acc[mt][nt][r];
            if (ok) {
              dst[col] = hv;
              if (MODE <= 1) hb[(size_t)row * 1024 + col] = f2bf(hv * (MODE == 0 ? p.nmix : p.n2)[col]);
            }
            sq += hv * hv;
          }
          v[m2 * 16 + r] = sq;
          if ((r & 3) == 3) asm volatile("" ::: "memory");
        }
      }
      const float tot = row_reduce32(v, lane);
      const int idx = lane & 31;
      const int row = row0 + wm * 128 + (mp * 2 + (idx >> 4)) * 32 + 8 * ((idx & 15) >> 2) + 4 * hh + (idx & 3);
      ssq[(size_t)row * 16 + ct * 4 + wn] = tot;
    }
  }
}

DI float rope_val(float val, int l32, int pos, const float* cosT, const float* sinT) {
  const float partner = __shfl_xor(val, 16);
  const int i = l32 & 15;
  const float2 cs2 = ((const float2*)cosT)[pos * 16 + i];
  const float cs = cs2.x, sn = cs2.y;
  (void)sinT;
  return l32 < 16 ? val * cs - partner * sn : val * cs + partner * sn;
}

DI void phase_inproj(const P& p, unsigned char* smem) {
  u16* lds = (u16*)smem;
  float* rs = (float*)(smem + RS_OFF);
  u16* projA = WSP(u16, OFF_PROJA);
  u16* projZ = WSP(u16, OFF_PROJZ);
  u16* kr = WSP(u16, OFF_KR);
  float* ba = WSP(float, OFF_BA);
  const float* cosT = WSP(float, OFF_ROPE);
  const float* sinT = cosT + L * 16;
  for (int tile = blockIdx.x; tile < NRT * 10; tile += gridDim.x) {
    int rt, ct;
    tile_map(tile, 10, rt, ct);
    const int row0 = rt * 256, col0 = ct * 256;
    __syncthreads();
    f32x16 acc[4][2];
    zero_acc(acc);
    gemm_accum<0>(acc, lds, p, WSP(u16, OFF_HB), 1024, nullptr, WSP(u16, OFF_WIN), 1024, 1024, row0, col0, RsReq{rs, WSP(float, OFF_SSQ1), 16, 1.f / 1024.f});
    TILE_SETUP
    const int g64 = ct * 4 + wn;
    if (g64 <= 5) {
      const float* nwp = g64 < 4 ? p.qn + g64 * 64 : p.kvn + (g64 - 4) * 64;
#pragma unroll
      for (int mp = 0; mp < 2; ++mp) {
        float v[32];
#pragma unroll
        for (int m2 = 0; m2 < 2; ++m2)
#pragma unroll
          for (int r = 0; r < 16; ++r) {
            const int mt = mp * 2 + m2;
            const int lr = LROW(mt, r), row = row0 + lr;
            const float sc = rs[lr];
            float sq = 0.f;
#pragma unroll
            for (int nt = 0; nt < 2; ++nt) {
              const int lc = nt * 32 + l32;
              const float val = acc[mt][nt][r] * sc;
              projA[(unsigned)(row * 2048 + g64 * 64 + lc)] = f2bf(val * nwp[lc]);
              sq += val * val;
            }
            v[m2 * 16 + r] = sq;
          }
        const float tot = row_reduce32(v, lane);
        const int idx = lane & 31;
        const int row = row0 + wm * 128 + (mp * 2 + (idx >> 4)) * 32 + 8 * ((idx & 15) >> 2) + 4 * hh + (idx & 3);
        if (g64 < 4) WSP(float, OFF_SSQQ)[(size_t)row * 4 + g64] = tot;
        else WSP(float, OFF_SSQKV)[(size_t)row * 2 + (g64 - 4)] = tot;
      }
    } else {
#pragma unroll
      for (int nt = 0; nt < 2; ++nt) {
        const int cb = g64 * 64 + nt * 32, col = cb + l32;
        if (cb == 384) {
#pragma unroll
          for (int mt = 0; mt < 4; ++mt)
#pragma unroll
            for (int r = 0; r < 16; ++r) {
              const int lr = LROW(mt, r), row = row0 + lr;
              const int rc = row < T ? row : T - 1;
              const float val = acc[mt][nt][r] * rs[lr];
              const float o = rope_val(val, l32, rc % L, cosT, sinT);
              kr[(unsigned)(row * 32 + l32)] = f2bf(o);
              if (r == 15) asm volatile("" ::: "memory");
            }
        } else {
#pragma unroll
          for (int mt = 0; mt < 4; ++mt)
#pragma unroll
            for (int r = 0; r < 16; ++r) {
              const int lr = LROW(mt, r), row = row0 + lr;
              const float val = acc[mt][nt][r] * rs[lr];
              if (col < 1952) projA[(unsigned)(row * 2048 + col)] = f2bf(val);
              else if (col < 1968) ba[(unsigned)(row * 16 + col - 1952)] = val;
              else if (col < 2480) projZ[(unsigned)(row * 512 + col - 1968)] = f2bf(val);
              if ((r & 3) == 3) asm volatile("" ::: "memory");
            }
        }
      }
    }
  }
}

DI void up_q_tile(const P& p, unsigned char* smem, int tile) {
  u16* lds = (u16*)smem;
  float* rs = (float*)(smem + RS_OFF);
  const int ct = tile % 3, rt = tile / 3, row0 = rt * 256, col0 = ct * 256;
  const float* cosT = WSP(float, OFF_ROPE);
  const float* sinT = cosT + L * 16;
  u16* qb = WSP(u16, OFF_Q);
  __syncthreads();
  f32x16 acc[4][2];
  zero_acc(acc);
  gemm_accum<0>(acc, lds, p, WSP(u16, OFF_PROJA), 2048, nullptr, WSP(u16, OFF_WUQ), 256, 256, row0, col0, RsReq{rs, WSP(float, OFF_SSQQ), 4, 1.f / 256.f});
  TILE_SETUP
  const int rb = row0 + wm * 128 + 4 * hh;
  const int rbc = rb < T ? rb : T - 1;
  const int pos0 = rbc % L;
#pragma unroll
  for (int nt = 0; nt < 2; ++nt) {
    const int cb = col0 + wn * 64 + nt * 32, col = cb + l32;
    const bool isrope = ((cb >> 5) % 3) == 2;
    if (isrope) {
      int pm = pos0;
#pragma unroll
      for (int mt = 0; mt < 4; ++mt) {
        int pg = pm;
#pragma unroll
        for (int g = 0; g < 4; ++g) {
#pragma unroll
          for (int e = 0; e < 4; ++e) {
            const int r = 4 * g + e;
            const int lr = LROW(mt, r), row = row0 + lr;
            int pos = pg + e;
            pos = pos >= L ? pos - L : pos;
            const float val = rope_val(acc[mt][nt][r] * rs[lr], l32, pos, cosT, sinT);
            qb[(unsigned)(row * 768 + col)] = f2bf(val * QSCALE);
          }
          asm volatile("" ::: "memory");
          __builtin_amdgcn_sched_barrier(0);
          pg += 8;
          pg = pg >= L ? pg - L : pg;
        }
        pm += 32;
        pm = pm >= L ? pm - L : pm;
      }
    } else {
#pragma unroll
      for (int mt = 0; mt < 4; ++mt)
#pragma unroll
        for (int r = 0; r < 16; ++r) {
          const int lr = LROW(mt, r), row = row0 + lr;
          qb[(unsigned)(row * 768 + col)] = f2bf(acc[mt][nt][r] * rs[lr] * QSCALE);
          if ((r & 3) == 3) { asm volatile("" ::: "memory"); __builtin_amdgcn_sched_barrier(0); }
        }
    }
  }
}
DI void up_kv_tile(const P& p, unsigned char* smem, int tile) {
  u16* lds = (u16*)smem;
  float* rs = (float*)(smem + RS_OFF);
  const int ct = tile % 4, rt = tile / 4, row0 = rt * 256, col0 = ct * 256;
  u16* kn = WSP(u16, OFF_KN);
  u16* vt = WSP(u16, OFF_VT);
  __syncthreads();
  f32x16 acc[4][2];
  zero_acc(acc);
  gemm_accum<0>(acc, lds, p, WSP(u16, OFF_PROJA) + 256, 2048, nullptr, WSP(u16, OFF_WUKV), 128, 128, row0, col0, RsReq{rs, WSP(float, OFF_SSQKV), 2, 1.f / 128.f});
  TILE_SETUP
  const int g64 = ct * 4 + wn, head = g64 >> 1;
  if ((g64 & 1) == 0) {
#pragma unroll
    for (int nt = 0; nt < 2; ++nt)
#pragma unroll
      for (int mt = 0; mt < 4; ++mt)
#pragma unroll
        for (int r = 0; r < 16; ++r) {
          const int lr = LROW(mt, r), row = row0 + lr;
          kn[(unsigned)(row * 512 + head * 64 + nt * 32 + l32)] = f2bf(acc[mt][nt][r] * rs[lr]);
          if ((r & 3) == 3) { asm volatile("" ::: "memory"); __builtin_amdgcn_sched_barrier(0); }
        }
  } else {
    const int rbase = row0 + wm * 128 + 4 * hh;
    const int b0 = rbase / L, bnd = (b0 + 1) * L;
    u16* vbase = vt + (size_t)(head * 64 + l32) * LP;
#pragma unroll
    for (int nt = 0; nt < 2; ++nt)
#pragma unroll
      for (int mt = 0; mt < 4; ++mt)
#pragma unroll
        for (int g = 0; g < 4; ++g) {
          const int row = rbase + mt * 32 + 8 * g, lr = row - row0;
          if (row < T) {
            const int b = row >= bnd ? b0 + 1 : b0, t = row - b * L;
            const unsigned off = (unsigned)((b * 512 + nt * 32) * LP + t);
            uint2 o = {pk2(acc[mt][nt][4 * g] * rs[lr], acc[mt][nt][4 * g + 1] * rs[lr + 1]),
                       pk2(acc[mt][nt][4 * g + 2] * rs[lr + 2], acc[mt][nt][4 * g + 3] * rs[lr + 3])};
            *(uint2*)(vbase + off) = o;
          }
          asm volatile("" ::: "memory");
          __builtin_amdgcn_sched_barrier(0);
        }
  }
}

DI void gdn_prep(const P& p, unsigned char* smem, int job) {
  const int tid = threadIdx.x, lane = tid & 63, w = tid >> 6, l32 = lane & 31, hh = lane >> 5;
  const int n = job % NCH, bh = job / NCH, hd = bh & 7, b = bh >> 3;
  float* qs = (float*)smem;
  float* ks = qs + 64 * 65;
  float* vs = ks + 64 * 65;
  float* Ls = vs + 64 * 65;
  float* gcs = Ls + 4096;
  float* betas = gcs + 64;
  float* egs = betas + 64;
  const u16* projA = WSP(u16, OFF_PROJA);
  const float* ba = WSP(float, OFF_BA);
  u16* cbase = WSP(u16, OFF_Y) + (size_t)job * 20480;
  u16* uT = cbase;
  u16* wnm = cbase + 4096;
  u16* qg = cbase + 8192;
  u16* intra = cbase + 12288;
  u16* kdT = cbase + 16384;
  const int t0 = 64 * n - 48;
  __syncthreads();
  {
    const int d = tid & 63, tg = tid >> 6;
    const int tb = t0 + tg * 8;
#pragma unroll
    for (int part = 0; part < 3; ++part) {
      const int ch = part * 512 + hd * 64 + d;
      const int col = 416 + ch;
      const float w0 = p.convw[ch], w1 = p.convw[1536 + ch], w2 = p.convw[2 * 1536 + ch], w3 = p.convw[3 * 1536 + ch];
      float* dst = part == 0 ? qs : (part == 1 ? ks : vs);
      auto ld = [&](int t) __attribute__((always_inline)) -> float { const float v_ = bf2f(projA[(size_t)(b * L + (t >= 0 ? t : 0)) * 2048 + col]); return t >= 0 ? v_ : 0.f; };
      float x0 = ld(tb - 3), x1 = ld(tb - 2), x2 = ld(tb - 1);
#pragma unroll
      for (int c = 0; c < 8; ++c) {
        const int t = tb + c;
        const float x3 = ld(t);
        const float y = w0 * x0 + w1 * x1 + w2 * x2 + w3 * x3;
        dst[(tg * 8 + c) * 65 + d] = t >= 0 ? fsilu(y) : 0.f;
        x0 = x1; x1 = x2; x2 = x3;
      }
    }
  }
  if (tid < 64) {
    const int t = t0 + tid;
    float beta = 0.f, g = 0.f;
    if (t >= 0) {
      const size_t row = (size_t)(b * L + t);
      const float braw = ba[row * 16 + hd], araw = ba[row * 16 + 8 + hd];
      beta = fsigmoid(braw);
      const float xx = araw + p.dtb[hd];
      const float sp = xx > 20.f ? xx : __logf(1.f + __expf(xx));
      g = -__expf(p.alog[hd]) * sp;
    }
    float gc = g;
#pragma unroll
    for (int off = 1; off < 64; off <<= 1) { float o = __shfl_up(gc, off); if (lane >= off) gc += o; }
    gcs[tid] = gc;
    betas[tid] = beta;
    egs[tid] = __expf(gc);
  }
  __syncthreads();
  if (tid < 256) {
    const int row = tid >> 2, q4 = tid & 3;
    float sq = 0.f, sk = 0.f;
#pragma unroll
    for (int j = 0; j < 16; ++j) { float a = qs[row * 65 + q4 * 16 + j], c = ks[row * 65 + q4 * 16 + j]; sq += a * a; sk += c * c; }
    sq += __shfl_xor(sq, 1); sq += __shfl_xor(sq, 2);
    sk += __shfl_xor(sk, 1); sk += __shfl_xor(sk, 2);
    const float fq = rsqrtf(sq + EPS) * 0.125f, fk = rsqrtf(sk + EPS);
#pragma unroll
    for (int j = 0; j < 16; ++j) { qs[row * 65 + q4 * 16 + j] *= fq; ks[row * 65 + q4 * 16 + j] *= fk; }
  }
  __syncthreads();
  {
    const int prod = w >> 2, mi = (w >> 1) & 1, ni = w & 1;
    f32x16 am;
#pragma unroll
    for (int r = 0; r < 16; ++r) am[r] = 0.f;
    if (!(mi == 0 && ni == 1)) {
      const float* ar_ = (prod == 0 ? ks : qs) + (32 * mi + l32) * 65 + hh;
      const float* kc_ = ks + (32 * ni + l32) * 65 + hh;
#pragma unroll 8
      for (int s2 = 0; s2 < 32; ++s2) am = MFMAF(ar_[2 * s2], kc_[2 * s2], am);
    }
#pragma unroll
    for (int r = 0; r < 16; ++r) {
      const int i = 32 * mi + 8 * (r >> 2) + 4 * hh + (r & 3), j = 32 * ni + l32;
      const float dec = i >= j ? __expf(gcs[i] - gcs[j]) : 0.f;
      if (prod == 0) Ls[i * 64 + j] = i > j ? am[r] * betas[i] * dec : 0.f;
      else intra[i * 64 + j] = f2bf(i >= j ? am[r] * dec : 0.f);
    }
  }
  __syncthreads();
  if (tid >= 128 && tid < 384) {
    const int col = tid & 63, part = (tid >> 6) - 2;
    const float glast = gcs[63];
    if (part < 2) {
#pragma unroll 8
      for (int ii = 0; ii < 32; ++ii) { const int i = part * 32 + ii; qg[i * 64 + col] = f2bf(qs[i * 65 + col] * egs[i]); }
    } else {
#pragma unroll
      for (int c4 = 0; c4 < 4; ++c4) {
        const int c8 = (part - 2) * 4 + c4;
        float e[8];
#pragma unroll
        for (int j = 0; j < 8; ++j) { const int i = c8 * 8 + j; e[j] = ks[i * 65 + col] * __expf(glast - gcs[i]); }
        uint4 o = {pk2(e[0], e[1]), pk2(e[2], e[3]), pk2(e[4], e[5]), pk2(e[6], e[7])};
        *(uint4*)(kdT + col * 64 + c8 * 8) = o;
      }
    }
    if (tid == 128) WSP(float, OFF_DEC)[job] = expf(glast);
  }
  if (tid < 128) {
    const int col = tid & 63;
    const bool isw = tid >= 64;
    float* xs = isw ? ks : vs;
    float X[64];
#pragma unroll
    for (int i = 0; i < 64; ++i) {
      float rhs = xs[i * 65 + col] * betas[i];
      if (isw) rhs *= egs[i];
      float a0 = rhs, a1 = 0.f, a2 = 0.f, a3 = 0.f;
      const float* lrow = Ls + i * 64;
#pragma unroll
      for (int j4 = 0; j4 < (i >> 2); ++j4) {
        const float4 l4 = *(const float4*)(lrow + 4 * j4);
        a0 -= l4.x * X[4 * j4];
        a1 -= l4.y * X[4 * j4 + 1];
        a2 -= l4.z * X[4 * j4 + 2];
        a3 -= l4.w * X[4 * j4 + 3];
      }
      if ((i & 3) >= 1) a0 -= lrow[(i & ~3)] * X[(i & ~3)];
      if ((i & 3) >= 2) a1 -= lrow[(i & ~3) + 1] * X[(i & ~3) + 1];
      if ((i & 3) >= 3) a2 -= lrow[(i & ~3) + 2] * X[(i & ~3) + 2];
      X[i] = (a0 + a1) + (a2 + a3);
      if ((i & 3) == 3) asm volatile("" ::: "memory");
    }
    if (!isw) {
#pragma unroll
      for (int c8 = 0; c8 < 8; ++c8) {
        float e[8];
#pragma unroll
        for (int j = 0; j < 8; ++j) e[j] = X[c8 * 8 + j];
        uint4 o = {pk2(e[0], e[1]), pk2(e[2], e[3]), pk2(e[4], e[5]), pk2(e[6], e[7])};
        *(uint4*)(uT + col * 64 + c8 * 8) = o;
      }
    } else {
      u16* wp = wnm + col;
#pragma unroll
      for (int i = 0; i < 64; ++i) { wp[i * 64] = f2bf(-X[i]); if ((i & 7) == 7) asm volatile("" ::: "memory"); }
    }
  }
}

DI void phase4(const P& p, unsigned char* smem) {
  int item = blockIdx.x;
  for (; item < NJOBS; item += gridDim.x) gdn_prep(p, smem, item);
  for (; item < NJOBS + NRT * 3; item += gridDim.x) up_q_tile(p, smem, item - NJOBS);
  for (; item < NJOBS + NRT * 7; item += gridDim.x) up_kv_tile(p, smem, item - NJOBS - NRT * 3);
  u16* vt = WSP(u16, OFF_VT);
  for (int idx = blockIdx.x * NTHR + threadIdx.x; idx < NB * 8 * 64 * 48; idx += gridDim.x * NTHR) {
    const int rowi = idx / 48, c = idx - rowi * 48;
    vt[(size_t)rowi * LP + L + c] = 0;
  }
}

DI void gdn_scan(const P& p, unsigned char* smem, int bh) {
  const int tid = threadIdx.x & 255, lane = tid & 63, w = tid >> 6, l32 = lane & 31, hh = lane >> 5;
  const int hd = bh & 7, b = bh >> 3;
  u16* ops = (u16*)smem;
  float* os = (float*)(smem + 5 * 64 * 68 * 2);
  const u16* gbase = WSP(u16, OFF_Y) + (size_t)bh * NCH * 20480;
  const float* decs = WSP(float, OFF_DEC) + bh * NCH;
  const u16* projZ = WSP(u16, OFF_PROJZ);
  u16* ogdn = WSP(u16, OFF_OGDN);
  f32x16 S[2];
#pragma unroll
  for (int r = 0; r < 16; ++r) { S[0][r] = 0.f; S[1][r] = 0.f; }
  uint4 st[10];
  auto gload = [&](int n) __attribute__((always_inline)) {
    const u16* src = gbase + (size_t)n * 20480;
#pragma unroll
    for (int i = 0; i < 10; ++i) st[i] = *(const uint4*)(src + (size_t)(tid + 256 * i) * 8);
  };
  auto sstore = [&]() __attribute__((always_inline)) {
#pragma unroll
    for (int i = 0; i < 10; ++i) {
      const int c = tid + 256 * i;
      u16* d = ops + (c >> 3) * 68 + (c & 7) * 8;
      *(uint2*)d = make_uint2(st[i].x, st[i].y);
      *(uint2*)(d + 4) = make_uint2(st[i].z, st[i].w);
    }
  };
  __syncthreads();
  gload(0);
  sstore();
  __syncthreads();
  for (int n = 0; n < NCH; ++n) {
    const float dS = decs[n];
    uint4 z0 = make_uint4(0u, 0u, 0u, 0u), z1 = z0;
    {
      const int i_ = tid >> 2, q4_ = tid & 3, t_ = 64 * n - 48 + i_;
      if (t_ >= 0) { const u16* zp_ = projZ + (size_t)(b * L + t_) * 512 + hd * 64 + q4_ * 16; z0 = *(const uint4*)zp_; z1 = *(const uint4*)(zp_ + 8); }
    }
    if (n + 1 < NCH) gload(n + 1);
    if (w < 2) {
      const int nh = w;
      const u16* uT = ops;
      const u16* wnm = ops + 64 * 68;
      const u16* qg = ops + 2 * 64 * 68;
      const u16* intra = ops + 3 * 64 * 68;
      const u16* kdT = ops + 4 * 64 * 68;
      bf16x8 Sb[4];
#pragma unroll
      for (int ks = 0; ks < 4; ++ks) Sb[ks] = pack8(S[ks >> 1], ks & 1);
      f32x16 vn[2];
#pragma unroll
      for (int mt = 0; mt < 2; ++mt)
#pragma unroll
        for (int g = 0; g < 4; ++g) {
          const uint2 uu = *(const uint2*)(uT + (32 * nh + l32) * 68 + 32 * mt + 8 * g + 4 * hh);
          vn[mt][4 * g + 0] = __uint_as_float(uu.x << 16);
          vn[mt][4 * g + 1] = __uint_as_float(uu.x & 0xffff0000u);
          vn[mt][4 * g + 2] = __uint_as_float(uu.y << 16);
          vn[mt][4 * g + 3] = __uint_as_float(uu.y & 0xffff0000u);
        }
#pragma unroll
      for (int mt = 0; mt < 2; ++mt)
#pragma unroll
        for (int ks = 0; ks < 4; ++ks) vn[mt] = MFMA(perm_read(wnm, 32 * mt + l32, 68, ks, hh), Sb[ks], vn[mt]);
      bf16x8 vb[4];
#pragma unroll
      for (int ks = 0; ks < 4; ++ks) vb[ks] = pack8(vn[ks >> 1], ks & 1);
      f32x16 oa[2];
#pragma unroll
      for (int r = 0; r < 16; ++r) { oa[0][r] = 0.f; oa[1][r] = 0.f; }
#pragma unroll
      for (int mt = 0; mt < 2; ++mt)
#pragma unroll
        for (int ks = 0; ks < 4; ++ks) {
          oa[mt] = MFMA(perm_read(qg, 32 * mt + l32, 68, ks, hh), Sb[ks], oa[mt]);
          oa[mt] = MFMA(perm_read(intra, 32 * mt + l32, 68, ks, hh), vb[ks], oa[mt]);
        }
#pragma unroll
      for (int mt = 0; mt < 2; ++mt) {
#pragma unroll
        for (int r = 0; r < 16; ++r) S[mt][r] *= dS;
#pragma unroll
        for (int ks = 0; ks < 4; ++ks) S[mt] = MFMA(perm_read(kdT, 32 * mt + l32, 68, ks, hh), vb[ks], S[mt]);
      }
#pragma unroll
      for (int mt = 0; mt < 2; ++mt)
#pragma unroll
        for (int r = 0; r < 16; ++r) os[(32 * mt + 8 * (r >> 2) + 4 * hh + (r & 3)) * 65 + 32 * nh + l32] = oa[mt][r];
    }
    __syncthreads();
    {
      const int i = tid >> 2, q4 = tid & 3;
      const int t = 64 * n - 48 + i;
      float ov[16];
      float ss = 0.f;
#pragma unroll
      for (int j = 0; j < 16; ++j) { ov[j] = os[i * 65 + q4 * 16 + j]; ss += ov[j] * ov[j]; }
      ss += __shfl_xor(ss, 1);
      ss += __shfl_xor(ss, 2);
      const float rstd = rsqrtf(ss * (1.f / 64.f) + EPS);
      if (t >= 0) {
        const size_t grow = (size_t)(b * L + t);
        const float* gw = p.gdnn + q4 * 16;
#define GZ(zw, j) pk2(ov[2 * (j)] * rstd * gw[2 * (j)] * fsilu(__uint_as_float((zw) << 16)), ov[2 * (j) + 1] * rstd * gw[2 * (j) + 1] * fsilu(__uint_as_float((zw) & 0xffff0000u)))
        const uint4 o0 = make_uint4(GZ(z0.x, 0), GZ(z0.y, 1), GZ(z0.z, 2), GZ(z0.w, 3));
        const uint4 o1 = make_uint4(GZ(z1.x, 4), GZ(z1.y, 5), GZ(z1.z, 6), GZ(z1.w, 7));
#undef GZ
        u16* op = ogdn + grow * 512 + hd * 64 + q4 * 16;
        *(uint4*)op = o0;
        *(uint4*)(op + 8) = o1;
      }
    }
    if (n + 1 < NCH) sstore();
    __syncthreads();
  }
}

constexpr int KLD = 104, VLD = 68;
constexpr int ATT_STAGE = 64 * KLD + 64 * VLD;
DI void attn_item(const P& p, unsigned char* smem, int qi, int bh) {
  const int tid = threadIdx.x & 255, lane = tid & 63, w = tid >> 6, l32 = lane & 31, hh = lane >> 5;
  const int b = bh >> 3, hd = bh & 7;
  const int q0 = qi == 0 ? 0 : 16 + 128 * (qi - 1);
  const int nrows = qi == 0 ? 16 : 128;
  const int ntile = (q0 + nrows - 1) / 64 + 1;
  u16* lds = (u16*)smem;
  const u16* qb = WSP(u16, OFF_Q);
  const u16* kn = WSP(u16, OFF_KN);
  const u16* kr = WSP(u16, OFF_KR);
  const u16* vt = WSP(u16, OFF_VT) + (size_t)(b * 8 + hd) * 64 * LP;
  const int qlocal = 32 * w + l32;
  const int qpos = q0 + qlocal;
  const int qposc = qpos < L ? qpos : L - 1;
  const int qmin_w = q0 + 32 * w, qmax_w = q0 + 32 * w + 31;
  bf16x8 Qf[6];
  {
    const u16* qp = qb + (size_t)(b * L + qposc) * 768 + hd * 96 + 8 * hh;
#pragma unroll
    for (int ks = 0; ks < 6; ++ks) Qf[ks] = *(const bf16x8*)(qp + 16 * ks);
  }
  uint4 rk0, rk1, rk2, rv0, rv1;
#define KLD_(i, dst)                                                                                  \
  {                                                                                                   \
    const int c = tid + 256 * (i), r = c / 12, kc = c - r * 12;                                       \
    const size_t grow = (size_t)(b * L + kv0_ + r);                                                   \
    const u16* src_ = kc < 8 ? kn + grow * 512 + hd * 64 + kc * 8 : kr + grow * 32 + (kc - 8) * 8;    \
    dst = *(const uint4*)src_;                                                                        \
  }
#define VLD_(i, dst)                                                                                  \
  {                                                                                                   \
    const int c = tid + 256 * (i), r = c >> 3, kc = c & 7;                                            \
    dst = *(const uint4*)(vt + (size_t)r * LP + kv0_ + kc * 8);                                       \
  }
#define A_LOAD(kt_) { const int kv0_ = (kt_) * 64; KLD_(0, rk0) KLD_(1, rk1) KLD_(2, rk2) VLD_(0, rv0) VLD_(1, rv1) }
#define KST_(i, v) { const int c = tid + 256 * (i), r = c / 12, kc = c - r * 12; *(uint4*)(Ks_ + r * KLD + kc * 8) = (v); }
#define VST_(i, v) { const int c = tid + 256 * (i), r = c >> 3, kc = c & 7; u16* d_ = Vs_ + r * VLD + kc * 8; *(uint2*)d_ = make_uint2((v).x, (v).y); *(uint2*)(d_ + 4) = make_uint2((v).z, (v).w); }
#define A_STORE(st_) { u16* Ks_ = lds + (st_) * ATT_STAGE; u16* Vs_ = Ks_ + 64 * KLD; KST_(0, rk0) KST_(1, rk1) KST_(2, rk2) VST_(0, rv0) VST_(1, rv1) }
  f32x16 ot[2];
#pragma unroll
  for (int r = 0; r < 16; ++r) { ot[0][r] = 0.f; ot[1][r] = 0.f; }
  float m = -INFINITY, lsum = 0.f;
  __syncthreads();
  A_LOAD(0);
  A_STORE(0);
  __syncthreads();
  for (int kt = 0; kt < ntile; ++kt) {
    if (kt + 1 < ntile) A_LOAD(kt + 1);
    const int kv0 = kt * 64;
    if (kv0 <= qmax_w) {
      const u16* Ks = lds + (kt & 1) * ATT_STAGE;
      const u16* Vs = Ks + 64 * KLD;
      f32x16 s[2];
#pragma unroll
      for (int r = 0; r < 16; ++r) { s[0][r] = 0.f; s[1][r] = 0.f; }
      bf16x8 kf[6][2];
#pragma unroll
      for (int ks = 0; ks < 6; ++ks)
#pragma unroll
        for (int mt = 0; mt < 2; ++mt) kf[ks][mt] = *(const bf16x8*)(Ks + (32 * mt + l32) * KLD + 16 * ks + 8 * hh);
      __builtin_amdgcn_sched_barrier(0);
#pragma unroll
      for (int ks = 0; ks < 6; ++ks)
#pragma unroll
        for (int mt = 0; mt < 2; ++mt) s[mt] = MFMA(kf[ks][mt], Qf[ks], s[mt]);
      bf16x8 vf[4][2];
#pragma unroll
      for (int ks = 0; ks < 4; ++ks)
#pragma unroll
        for (int mt = 0; mt < 2; ++mt) vf[ks][mt] = perm_read(Vs, 32 * mt + l32, VLD, ks, hh);
      __builtin_amdgcn_sched_barrier(0);
      if (kv0 + 63 > qmin_w) {
#pragma unroll
        for (int mt = 0; mt < 2; ++mt)
#pragma unroll
          for (int r = 0; r < 16; ++r) {
            const int key = kv0 + 32 * mt + 8 * (r >> 2) + 4 * hh + (r & 3);
            if (key > qpos) s[mt][r] = -INFINITY;
          }
      }
      float mx = s[0][0];
#pragma unroll
      for (int r = 1; r < 16; ++r) mx = fmaxf(mx, s[0][r]);
#pragma unroll
      for (int r = 0; r < 16; ++r) mx = fmaxf(mx, s[1][r]);
      mx = fmaxf(mx, __shfl_xor(mx, 32));
      const float mnew = fmaxf(m, mx);
      const float alpha = __builtin_amdgcn_exp2f(m - mnew);
      m = mnew;
      float ps = 0.f;
#pragma unroll
      for (int mt = 0; mt < 2; ++mt)
#pragma unroll
        for (int r = 0; r < 16; ++r) { const float e = __builtin_amdgcn_exp2f(s[mt][r] - mnew); s[mt][r] = e; ps += e; }
      lsum = lsum * alpha + ps;
      if (__builtin_amdgcn_ballot_w64(alpha != 1.f) != 0ull) {
#pragma unroll
        for (int r = 0; r < 16; ++r) { ot[0][r] *= alpha; ot[1][r] *= alpha; }
      }
      bf16x8 pb[4];
#pragma unroll
      for (int ks = 0; ks < 4; ++ks) pb[ks] = pack8(s[ks >> 1], ks & 1);
#pragma unroll
      for (int ks = 0; ks < 4; ++ks)
#pragma unroll
        for (int mt = 0; mt < 2; ++mt) ot[mt] = MFMA(vf[ks][mt], pb[ks], ot[mt]);
    }
    if (kt + 1 < ntile) A_STORE((kt + 1) & 1);
    __syncthreads();
  }
#undef A_LOAD
#undef A_STORE
  lsum += __shfl_xor(lsum, 32);
  const float inv = 1.f / lsum;
  if (qlocal < nrows && qpos < L) {
    u16* op = WSP(u16, OFF_OMLA) + (size_t)(b * L + qpos) * 512 + hd * 64;
#pragma unroll
    for (int mt = 0; mt < 2; ++mt)
#pragma unroll
      for (int g = 0; g < 4; ++g) {
        uint2 o = {pk2(ot[mt][4 * g] * inv, ot[mt][4 * g + 1] * inv), pk2(ot[mt][4 * g + 2] * inv, ot[mt][4 * g + 3] * inv)};
        *(uint2*)(op + 32 * mt + 8 * g + 4 * hh) = o;
      }
  }
}

DI void hb1_item(const P& p, int rt) {
  const int tid = threadIdx.x & 255, lane = tid & 63, w = tid >> 6;
  u16* hb1 = WSP(u16, OFF_HB1);
  float4 g[4];
#pragma unroll
  for (int i = 0; i < 4; ++i) g[i] = *(const float4*)(p.nmix + lane * 4 + 256 * i);
  for (int rr = 0; rr < 32; rr += 4) {
    const int r0 = rt * 128 + w * 32 + rr;
    if (r0 >= T) break;
    float4 v[4][4];
#pragma unroll
    for (int q = 0; q < 4; ++q) {
      const float* src = hrow(p, r0 + q);
#pragma unroll
      for (int i = 0; i < 4; ++i) v[q][i] = *(const float4*)(src + lane * 4 + 256 * i);
    }
#pragma unroll
    for (int q = 0; q < 4; ++q)
#pragma unroll
      for (int i = 0; i < 4; ++i) {
        uint2 o = {pk2(v[q][i].x * g[i].x, v[q][i].y * g[i].y), pk2(v[q][i].z * g[i].z, v[q][i].w * g[i].w)};
        *(uint2*)(hb1 + (size_t)(r0 + q) * 1024 + lane * 4 + 256 * i) = o;
      }
  }
}

constexpr int NATTP = 33 * 16, NHB1P = 65;
DI void phase5(const P& p, unsigned char* smem) {
  const int half = (__builtin_amdgcn_readfirstlane(threadIdx.x >> 8) & 1);
  unsigned char* hsm = smem + half * HALF_SMEM;
  if (blockIdx.x < 16) gdn_scan(p, hsm, 2 * blockIdx.x + half);
  int* sitem = (int*)(smem + 2 * HALF_SMEM);
  int* cnt = WSP(int, OFF_CNT);
  for (;;) {
    __syncthreads();
    if (threadIdx.x == 0) *sitem = atomicAdd(cnt, 1);
    __syncthreads();
    const int ip = *sitem;
    if (ip >= NATTP + NHB1P) break;
    if (ip < NATTP) attn_item(p, hsm, 32 - (ip >> 4), 2 * (ip & 15) + half);
    else hb1_item(p, 2 * (ip - NATTP) + half);
  }
}

DI void phase_merge(const P& p, unsigned char* smem) {
  u16* lds = (u16*)smem;
  float* rs = (float*)(smem + RS_OFF);
  u16* merged = WSP(u16, OFF_MERGED);
  for (int tile = blockIdx.x; tile < NRT * 4; tile += gridDim.x) {
    int rt, ct;
    tile_map(tile, 4, rt, ct);
    const int row0 = rt * 256, col0 = ct * 256;
    __syncthreads();
    f32x16 acc[4][2];
    u16* slotB = WSP(u16, OFF_HB);
#define CB4 if ((r & 3) == 3) { asm volatile("" ::: "memory"); __builtin_amdgcn_sched_barrier(0); }
#define CB16 if (nt == 1 && r == 15) { asm volatile("" ::: "memory"); __builtin_amdgcn_sched_barrier(0); }
#define EIDX(mt, nt, r) ((unsigned)(row0 + LROW(mt, r)) * 1024u + (unsigned)(col0 + wn * 64 + (nt) * 32 + l32) + ob)
#define OPQ unsigned ob = 0; asm volatile("" : "+v"(ob));
#define ELOOP _Pragma("unroll") for (int mt = 0; mt < 4; ++mt) _Pragma("unroll") for (int nt = 0; nt < 2; ++nt) _Pragma("unroll") for (int r = 0; r < 16; ++r)
    zero_acc(acc);
    gemm_accum<0>(acc, lds, p, WSP(u16, OFF_HB1), 1024, nullptr, WSP(u16, OFF_WGG), 1024, 1024, row0, col0, RsReq{rs, WSP(float, OFF_SSQ1), 16, 1.f / 1024.f});
    { TILE_SETUP OPQ
      ELOOP {
        merged[EIDX(mt, nt, r)] = f2bf(fsigmoid(acc[mt][nt][r] * rs[LROW(mt, r) + ob]));
        CB4
      }
    }
    zero_acc(acc);
    gemm_accum<0>(acc, lds, p, WSP(u16, OFF_HB1), 1024, nullptr, WSP(u16, OFF_WGM), 1024, 1024, row0, col0);
    { TILE_SETUP OPQ
      ELOOP {
        slotB[EIDX(mt, nt, r)] = f2bf(fmaxf(fsigmoid(acc[mt][nt][r] * rs[LROW(mt, r) + ob]), 1e-6f));
        CB4
      }
    }
  }
  for (int tile = blockIdx.x; tile < NRT * 4; tile += gridDim.x) {
    int rt, ct;
    tile_map(tile, 4, rt, ct);
    const int row0 = rt * 256, col0 = ct * 256;
    f32x16 acc[4][2];
    u16* slotB = WSP(u16, OFF_HB);
    zero_acc(acc);
    gemm_accum<0>(acc, lds, p, WSP(u16, OFF_OGDN), 512, nullptr, WSP(u16, OFF_WGO), 512, 512, row0, col0);
    { TILE_SETUP OPQ
      ELOOP {
        const unsigned e = EIDX(mt, nt, r);
        merged[e] = f2bf(acc[mt][nt][r] * bf2f(merged[e]));
        CB16
      }
    }
    zero_acc(acc);
    gemm_accum<0>(acc, lds, p, WSP(u16, OFF_OMLA), 512, nullptr, WSP(u16, OFF_WMO), 512, 512, row0, col0);
    { TILE_SETUP OPQ
      ELOOP {
        const unsigned e = EIDX(mt, nt, r);
        merged[e] = f2bf(bf2f(merged[e]) + acc[mt][nt][r] * bf2f(slotB[e]));
        CB16
      }
    }
#undef CB4
#undef CB16
#undef EIDX
#undef OPQ
#undef ELOOP
  }
  const int half = (__builtin_amdgcn_readfirstlane(otid() >> 8) & 1);
  float* ts = (float*)(smem + half * HALF_SMEM);
  for (int ip = obid(); ip < 352 * 3; ip += gridDim.x) {
    int it = 2 * ip + half;
    if (tr_try(it, TrDesc{p.wg2, 2816, 1024, 2816, 16, 44, WSP(u16, OFF_W1T), 1}, ts)) continue;
    if (tr_try(it, TrDesc{p.wu2, 2816, 1024, 2816, 16, 44, WSP(u16, OFF_W1T), 2}, ts)) continue;
    if (tr_try(it, TrDesc{p.wd2, 1024, 2816, 1024, 44, 16, WSP(u16, OFF_W2T), 0}, ts)) continue;
  }
}

DI void phase_final(const P& p) {
  const int tid = otid(), lane = tid & 63, w = tid >> 6;
  const int bid = obid();
  const float* ssq = WSP(float, OFF_SSQ3);
  float4 g[4];
#pragma unroll
  for (int i = 0; i < 4; ++i) g[i] = *(const float4*)(p.nf + lane * 4 + 256 * i);
  for (int orow0 = (bid * 8 + w) * 4; orow0 < NB * 4096; orow0 += gridDim.x * 8 * 4) {
    float4 v[4][4];
    float4 q0[4], q1[4], q2[4], q3[4];
#pragma unroll
    for (int q = 0; q < 4; ++q) {
      const int orow = orow0 + q, b = orow >> 12, s_ = orow & 4095, r = b * L + 16 + s_;
      const float* sp = ssq + (size_t)r * 16;
      q0[q] = *(const float4*)sp; q1[q] = *(const float4*)(sp + 4); q2[q] = *(const float4*)(sp + 8); q3[q] = *(const float4*)(sp + 12);
      const float* op = p.out + (size_t)orow * 1024;
#pragma unroll
      for (int i = 0; i < 4; ++i) v[q][i] = *(const float4*)(op + lane * 4 + 256 * i);
    }
#pragma unroll
    for (int q = 0; q < 4; ++q) {
      const float a = ((q0[q].x + q0[q].y) + (q0[q].z + q0[q].w)) + ((q1[q].x + q1[q].y) + (q1[q].z + q1[q].w)) +
                      ((q2[q].x + q2[q].y) + (q2[q].z + q2[q].w)) + ((q3[q].x + q3[q].y) + (q3[q].z + q3[q].w));
      const float rstd = rsqrtf(a * (1.f / 1024.f) + EPS);
      float* op = p.out + (size_t)(orow0 + q) * 1024;
#pragma unroll
      for (int i = 0; i < 4; ++i) {
        float4 o = v[q][i];
        o.x *= rstd * g[i].x; o.y *= rstd * g[i].y; o.z *= rstd * g[i].z; o.w *= rstd * g[i].w;
        *(float4*)(op + lane * 4 + 256 * i) = o;
      }
    }
  }
}

#define XB_TMO      128
#define XB_XCNT(j)  (256  + 64 * (j))
#define XB_XSUB(j)  (1280 + 64 * (j))
#define XB_XGEN(j)  (2304 + 64 * (j))
#define XB_TOP      3328
#define XB_TOPGEN   3392
#define XB_SPIN_CAP (1u << 22)
#define LAS __attribute__((address_space(3)))
DI unsigned xb_ld(unsigned* p) { return __hip_atomic_load(p, __ATOMIC_RELAXED, __HIP_MEMORY_SCOPE_AGENT); }
DI unsigned xb_add(unsigned* p, unsigned v) { return __hip_atomic_fetch_add(p, v, __ATOMIC_RELAXED, __HIP_MEMORY_SCOPE_AGENT); }
DI unsigned xb_xcc_id() { return (unsigned)__builtin_amdgcn_s_getreg((3 << 11) | 20) & 0xFu; }
#define XB_SPIN(cond, bar) do { unsigned _sp = 0; while (cond) { __builtin_amdgcn_s_sleep(1); \
    if ((++_sp & 255u) == 0u) { if (xb_ld(&(bar)[XB_TMO])) break; if (_sp > XB_SPIN_CAP) { atomicAdd(&(bar)[XB_TMO], 1u); break; } } } } while (0)
struct XcdBarrier { unsigned* bar; unsigned x; volatile LAS unsigned* st; };
DI XcdBarrier xcd_barrier_post(unsigned* bar, volatile LAS unsigned* st) {
  XcdBarrier b; b.bar = bar; b.x = xb_xcc_id(); b.st = st;
  if (threadIdx.x == 0) (void)xb_add(&bar[XB_XCNT(b.x)], 1u);
  return b;
}
DI void xcd_barrier_complete(unsigned* bar, unsigned x, unsigned& nloc, unsigned& nx) {
  const unsigned G = gridDim.x * gridDim.y * gridDim.z;
  unsigned sum, cnt, mine, sp = 0u;
  for (;;) {
    sum = 0u; cnt = 0u; mine = 0u;
#pragma unroll
    for (unsigned j = 0; j < 16; ++j) { const unsigned c = xb_ld(&bar[XB_XCNT(j)]); sum += c; cnt += (c > 0u) ? 1u : 0u; mine = (j == x) ? c : mine; }
    if (sum == G) break;
    __builtin_amdgcn_s_sleep(1);
    if ((++sp & 255u) == 0u) { if (xb_ld(&bar[XB_TMO])) break; if (sp > XB_SPIN_CAP) { atomicAdd(&bar[XB_TMO], 1u); break; } }
  }
  nloc = mine > 0u ? mine : 1u; nx = cnt > 0u ? cnt : 1u;
}
DI void xcd_barrier(const XcdBarrier& b) {
  asm volatile("s_waitcnt vmcnt(0)" ::: "memory");
  __syncthreads();
  if (threadIdx.x == 0) {
    unsigned* bar = b.bar;
    __builtin_amdgcn_s_waitcnt(0);
    unsigned nloc = b.st[0], nx = b.st[1];
    if (nloc == 0u) { xcd_barrier_complete(bar, b.x, nloc, nx); b.st[0] = nloc; b.st[1] = nx; }
    const unsigned old = xb_add(&bar[XB_XSUB(b.x)], 1u);
    const unsigned gen = old / nloc;
    if (old + 1u == (gen + 1u) * nloc) {
      __builtin_amdgcn_fence(__ATOMIC_RELEASE, "agent");
      asm volatile("s_waitcnt vmcnt(0)" ::: "memory");
      const unsigned og = xb_add(&bar[XB_TOP], 1u);
      const unsigned tg = og / nx;
      if (og + 1u == (tg + 1u) * nx) xb_add(&bar[XB_TOPGEN], 1u);
      else XB_SPIN(xb_ld(&bar[XB_TOPGEN]) == tg, bar);
      __builtin_amdgcn_fence(__ATOMIC_ACQUIRE, "agent");
      xb_add(&bar[XB_XGEN(b.x)], 1u);
      asm volatile("s_waitcnt vmcnt(0)" ::: "memory");
    } else {
      XB_SPIN(xb_ld(&bar[XB_XGEN(b.x)]) == gen, bar);
      __builtin_amdgcn_fence(__ATOMIC_ACQUIRE, "agent");
      asm volatile("s_waitcnt vmcnt(0)" ::: "memory");
    }
  }
  __syncthreads();
}

template <int PH>
DI void run_phase(const P& p, unsigned char* smem) {
  if (PH == 0) phase0(p, smem);
  else if (PH == 1) phase_gateup(p, smem, WSP(u16, OFF_W1T), WSP(float, OFF_SSQ0));
  else if (PH == 2) phase_resid<0>(p, smem);
  else if (PH == 3) phase_inproj(p, smem);
  else if (PH == 4) phase4(p, smem);
  else if (PH == 5) phase5(p, smem);
  else if (PH == 6) phase_merge(p, smem);
  else if (PH == 7) phase_resid<1>(p, smem);
  else if (PH == 8) phase_gateup(p, smem, WSP(u16, OFF_W1T), WSP(float, OFF_SSQ2));
  else if (PH == 9) phase_resid<2>(p, smem);
  else phase_final(p);
}

#if MULTI
template <int PH>
__global__ void __launch_bounds__(NTHR, 1) k_phase(P p) {
  __shared__ __attribute__((aligned(16))) unsigned char smem[SMEM_BYTES];
  run_phase<PH>(p, smem);
}
#else
__global__ void __launch_bounds__(NTHR, 1) k_mega(P p) {
  __shared__ __attribute__((aligned(16))) unsigned char smem[SMEM_BYTES];
  cg::grid_group grid = cg::this_grid();
  __shared__ uint4 xb_words;
  if (threadIdx.x == 0) xb_words = make_uint4(0u, 0u, 0u, 0u);
  __syncthreads();
  const XcdBarrier xb = xcd_barrier_post(WSP(unsigned, OFF_BAR), (volatile LAS unsigned*)&xb_words);
  run_phase<0>(p, smem); xcd_barrier(xb);
  if (p.ws == nullptr) grid.sync();
  run_phase<1>(p, smem); xcd_barrier(xb);
  run_phase<2>(p, smem); xcd_barrier(xb);
  run_phase<3>(p, smem); xcd_barrier(xb);
  run_phase<4>(p, smem); xcd_barrier(xb);
  run_phase<5>(p, smem); xcd_barrier(xb);
  run_phase<6>(p, smem); xcd_barrier(xb);
  run_phase<7>(p, smem); xcd_barrier(xb);
  run_phase<8>(p, smem); xcd_barrier(xb);
  run_phase<9>(p, smem); xcd_barrier(xb);
  run_phase<10>(p, smem);
}
#endif

extern "C" void kernel_launch(void* const* d_in, const int* in_sizes, int n_in, void* d_out, int out_size, void* d_ws, size_t ws_size,
                              hipStream_t stream) {
  if (n_in != 24 || ws_size < WS_TOTAL) { fprintf(stderr, "kernel_launch: unexpected n_in %d or ws_size %zu (< %zu)\n", n_in, ws_size, (size_t)WS_TOTAL); return; }
  P p{};
  const float** pp = (const float**)&p;
  for (int i = 0; i < 24; ++i) pp[i] = (const float*)d_in[i];
  p.out = (float*)d_out;
  p.ws = (unsigned char*)d_ws;
#if MULTI
  const int G = 256;
#define LAUNCH(PH) hipLaunchKernelGGL(k_phase<PH>, dim3(G), dim3(NTHR), 0, stream, p)
  LAUNCH(0); LAUNCH(1); LAUNCH(2); LAUNCH(3); LAUNCH(4); LAUNCH(5); LAUNCH(6); LAUNCH(7); LAUNCH(8); LAUNCH(9); LAUNCH(10);
#else
  static int grid_blocks = 0;
  if (!grid_blocks) {
    int dev = 0, cus = 0, per_cu = 0;
    hipGetDevice(&dev);
    hipDeviceGetAttribute(&cus, hipDeviceAttributeMultiprocessorCount, dev);
    hipOccupancyMaxActiveBlocksPerMultiprocessor(&per_cu, k_mega, NTHR, 0);
    if (per_cu < 1) per_cu = 1;
    if (per_cu > 1) per_cu = 1;
    grid_blocks = cus * per_cu;
  }
  if (hipMemsetAsync((char*)d_ws + OFF_BAR, 0, BAR_BYTES + SKC_BYTES, stream) != hipSuccess) { fprintf(stderr, "memset of barrier words failed\n"); return; }
  void* args[] = {&p};
  hipError_t e = hipLaunchCooperativeKernel((void*)k_mega, dim3(grid_blocks), dim3(NTHR), args, 0, stream);
  if (e != hipSuccess) fprintf(stderr, "cooperative launch failed: %s (grid %d)\n", hipGetErrorString(e), grid_blocks);
#endif
}
```
